# Optimizing an MI355X kernel written in HIP

```python
import math
import jax, jax.numpy as jnp
from jax import lax
import numpy as np

D_MODEL = 1024
BATCH = 2
SEQ = 16384
DEPTH = 1

MEM_LEN = 256
EPS = 1e-6

SSD_HEADS = 16
SSD_HEAD_DIM = 64
SSD_DIM = SSD_HEADS * SSD_HEAD_DIM
SSD_GROUPS = 2
SSD_HEADS_PER_GROUP = SSD_HEADS // SSD_GROUPS
SSD_STATE = 128
SSD_CONV = 4
SSD_CHUNK = 128
SSD_CONV_CH = SSD_DIM + 2 * SSD_GROUPS * SSD_STATE

HG_HEADS = 8
HG_K = 128
HG_V = 128
HG_KDIM = HG_HEADS * HG_K
HG_VDIM = HG_HEADS * HG_V
HG_CHUNK = 64

D_MIX = SSD_DIM + HG_VDIM
N_IN = SSD_DIM + SSD_CONV_CH + SSD_HEADS + 2 * HG_KDIM + 2 * HG_VDIM

XA_HEADS = 4
XA_HEAD_DIM = D_MODEL // XA_HEADS

FFN_DIM = -(-8 * D_MODEL // (3 * 256)) * 256

kernel_name = "hybrid_ssd_hgrn2_xattn_block"


def rmsnorm(x, w):
    xf = x.astype(jnp.float32)
    y = xf * lax.rsqrt(jnp.mean(xf * xf, axis=-1, keepdims=True) + EPS)
    return (y * w.astype(jnp.float32)).astype(x.dtype)


def causal_depthwise_conv(u, w, b):
    ch = u.shape[-1]
    out = lax.conv_general_dilated(
        u, w[:, None, :].astype(u.dtype), window_strides=(1,),
        padding=[(w.shape[0] - 1, 0)], dimension_numbers=("NWC", "WIO", "NWC"),
        feature_group_count=ch)
    return out + b.astype(u.dtype)


def ssd_mixer(xs, bm, cm, dt, a_log, d_skip):
    bsz, seqlen = xs.shape[0], xs.shape[1]
    nc, q = seqlen // SSD_CHUNK, SSD_CHUNK
    g, e, p, n = SSD_GROUPS, SSD_HEADS_PER_GROUP, SSD_HEAD_DIM, SSD_STATE
    a = -jnp.exp(a_log.astype(jnp.float32)).reshape(g, e)
    x_c = xs.reshape(bsz, nc, q, g, e, p)
    b_c = bm.reshape(bsz, nc, q, g, n)
    c_c = cm.reshape(bsz, nc, q, g, n)
    dt_c = dt.reshape(bsz, nc, q, g, e)
    acum = jnp.cumsum(jnp.moveaxis(dt_c * a, 2, -1), axis=-1)
    causal = jnp.tril(jnp.ones((q, q), dtype=bool))
    seg = acum[..., :, None] - acum[..., None, :]
    l_dec = jnp.exp(jnp.where(causal, seg, -jnp.inf))
    xdt = x_c * dt_c[..., None]
    cb = jnp.einsum("bclgn,bcsgn->bcgls", c_c, b_c)
    y_diag = jnp.einsum("bcgels,bcsgep->bclgep", cb[:, :, :, None] * l_dec, xdt)
    dec_to_end = jnp.moveaxis(jnp.exp(acum[..., -1:] - acum), -1, 2)
    states = jnp.einsum("bcsgn,bcsgep->bcgepn", b_c, xdt * dec_to_end[..., None])
    chunk_decay = jnp.exp(acum[..., -1])

    def step(s, inp):
        st, dec = inp
        return s * dec[..., None, None] + st, s

    s0 = jnp.zeros((bsz, g, e, p, n), jnp.float32)
    _, s_in = lax.scan(step, s0, (jnp.moveaxis(states, 1, 0).astype(jnp.float32),
                                  jnp.moveaxis(chunk_decay, 1, 0)))
    s_in = jnp.moveaxis(s_in, 0, 1)
    dec_from_start = jnp.moveaxis(jnp.exp(acum), -1, 2)
    y_off = jnp.einsum("bclgn,bcgepn->bclgep", c_c, s_in) * dec_from_start[..., None]
    y = (y_diag + y_off).reshape(bsz, seqlen, SSD_HEADS, p)
    return y + d_skip.astype(jnp.float32)[:, None] * xs


def hgrn2_mixer(q_raw, f_raw, i_val, lb):
    bsz, seqlen = q_raw.shape[0], q_raw.shape[1]
    nc, c = seqlen // HG_CHUNK, HG_CHUNK
    qf = jax.nn.silu(q_raw)
    fg = lb + (1.0 - lb) * jax.nn.sigmoid(f_raw.astype(jnp.float32))
    kf = 1.0 - fg
    gl = jnp.log(fg)

    def to_chunks(t):
        return t.reshape(bsz, nc, c, t.shape[2], t.shape[3]).transpose(1, 0, 3, 2, 4)

    causal = jnp.tril(jnp.ones((c, c), dtype=bool))[:, :, None]

    def step(s, inp):
        qc, kc, vc, gc = inp
        bcum = jnp.cumsum(gc, axis=2)
        o_inter = jnp.einsum("bhqk,bhkv->bhqv", qc * jnp.exp(bcum), s)
        seg = bcum[:, :, :, None, :] - bcum[:, :, None, :, :]
        dec = jnp.exp(jnp.where(causal, seg, -jnp.inf))
        att = jnp.einsum("bhik,bhijk->bhij", qc, dec * kc[:, :, None, :, :])
        o_intra = jnp.einsum("bhij,bhjv->bhiv", att, vc)
        b_last = bcum[:, :, -1:, :]
        s_new = s * jnp.exp(b_last[:, :, 0, :])[..., None] + jnp.einsum(
            "bhjk,bhjv->bhkv", kc * jnp.exp(b_last - bcum), vc)
        return s_new, (o_inter + o_intra).astype(jnp.float32)

    s0 = jnp.zeros((bsz, HG_HEADS, HG_K, HG_V), jnp.float32)
    _, o = lax.scan(step, s0, (to_chunks(qf), to_chunks(kf), to_chunks(i_val), to_chunks(gl)))
    return o.transpose(1, 0, 3, 2, 4).reshape(bsz, seqlen, HG_HEADS, HG_V)


def setup_inputs(seed: int = 0) -> dict:
    key = jax.random.key(seed)
    ks = jax.random.split(key, 24)
    f32 = jnp.float32

    def nrm(k, shape, scale):
        return jax.random.normal(k, shape, f32) * scale

    def gain(k, shape):
        return 1.0 + 0.02 * jax.random.normal(k, shape, f32)

    dt = jnp.exp(jax.random.uniform(ks[5], (DEPTH, SSD_HEADS), f32)
                 * (math.log(0.1) - math.log(0.001)) + math.log(0.001))
    return {
        "x": nrm(ks[0], (BATCH, SEQ, D_MODEL), 1.0),
        "mem": nrm(ks[1], (BATCH, MEM_LEN, D_MODEL), 1.0),
        "norm_mix_w": gain(ks[2], (DEPTH, D_MODEL)),
        "w_in": nrm(ks[3], (DEPTH, D_MODEL, N_IN), D_MODEL ** -0.5),
        "conv_w": nrm(ks[4], (DEPTH, SSD_CONV, SSD_CONV_CH), SSD_CONV ** -0.5),
        "conv_b": nrm(ks[6], (DEPTH, SSD_CONV_CH), 0.02),
        "dt_bias": dt + jnp.log(-jnp.expm1(-dt)),
        "a_log": jnp.log(jax.random.uniform(ks[7], (DEPTH, SSD_HEADS), f32, 1.0, 16.0)),
        "d_skip": 1.0 + 0.1 * jax.random.normal(ks[8], (DEPTH, SSD_HEADS), f32),
        "ssd_norm_w": gain(ks[9], (DEPTH, SSD_DIM)),
        "hg_lower_bounds": nrm(ks[10], (DEPTH + 1, HG_KDIM), 0.5),
        "hg_norm_w": gain(ks[11], (DEPTH, HG_V)),
        "w_out": nrm(ks[12], (DEPTH, D_MIX, D_MODEL), D_MIX ** -0.5),
        "norm_xa_w": gain(ks[13], (DEPTH, D_MODEL)),
        "norm_mem_w": gain(ks[14], (DEPTH, D_MODEL)),
        "xa_wq": nrm(ks[15], (DEPTH, D_MODEL, D_MODEL), D_MODEL ** -0.5),
        "xa_wkv": nrm(ks[16], (DEPTH, D_MODEL, 2 * D_MODEL), D_MODEL ** -0.5),
        "xa_wo": nrm(ks[17], (DEPTH, D_MODEL, D_MODEL), D_MODEL ** -0.5),
        "norm_ffn_w": gain(ks[18], (DEPTH, D_MODEL)),
        "ffn_w_gate": nrm(ks[19], (DEPTH, D_MODEL, FFN_DIM), D_MODEL ** -0.5),
        "ffn_w_up": nrm(ks[20], (DEPTH, D_MODEL, FFN_DIM), D_MODEL ** -0.5),
        "ffn_w_down": nrm(ks[21], (DEPTH, FFN_DIM, D_MODEL), FFN_DIM ** -0.5),
        "norm_final_w": gain(ks[22], (D_MODEL,)),
    }


def reference(x, mem, norm_mix_w, w_in, conv_w, conv_b, dt_bias, a_log, d_skip, ssd_norm_w,
              hg_lower_bounds, hg_norm_w, w_out, norm_xa_w, norm_mem_w, xa_wq, xa_wkv, xa_wo,
              norm_ffn_w, ffn_w_gate, ffn_w_up, ffn_w_down, norm_final_w):
    bsz, seqlen, _ = x.shape
    lb_all = jnp.cumsum(jax.nn.softmax(hg_lower_bounds.astype(jnp.float32), axis=0), axis=0)
    s1 = SSD_DIM
    s2 = s1 + SSD_CONV_CH
    s3 = s2 + SSD_HEADS
    s4 = s3 + HG_KDIM
    s5 = s4 + HG_KDIM
    s6 = s5 + HG_VDIM
    for l in range(DEPTH):
        h = rmsnorm(x, norm_mix_w[l])
        proj = h @ w_in[l]
        z, xbc, dt_raw, hq, hf, hi, hgate = jnp.split(proj, [s1, s2, s3, s4, s5, s6], axis=-1)
        xbc = jax.nn.silu(causal_depthwise_conv(xbc, conv_w[l], conv_b[l]))
        xs, bm, cm = jnp.split(xbc, [SSD_DIM, SSD_DIM + SSD_GROUPS * SSD_STATE], axis=-1)
        dt = jax.nn.softplus((dt_raw + dt_bias[l]).astype(jnp.float32))
        y_a = ssd_mixer(xs.reshape(bsz, seqlen, SSD_HEADS, SSD_HEAD_DIM),
                        bm.reshape(bsz, seqlen, SSD_GROUPS, SSD_STATE),
                        cm.reshape(bsz, seqlen, SSD_GROUPS, SSD_STATE),
                        dt, a_log[l], d_skip[l])
        yz = (y_a.reshape(bsz, seqlen, SSD_DIM) * jax.nn.silu(z)).reshape(
            bsz, seqlen, SSD_GROUPS, SSD_DIM // SSD_GROUPS)
        y_a = rmsnorm(yz, ssd_norm_w[l].reshape(SSD_GROUPS, -1)).reshape(bsz, seqlen, SSD_DIM)
        o_b = hgrn2_mixer(hq.reshape(bsz, seqlen, HG_HEADS, HG_K),
                          hf.reshape(bsz, seqlen, HG_HEADS, HG_K),
                          hi.reshape(bsz, seqlen, HG_HEADS, HG_V),
                          lb_all[l].reshape(HG_HEADS, HG_K))
        o_b = rmsnorm(o_b, hg_norm_w[l]) * jax.nn.silu(hgate.reshape(bsz, seqlen, HG_HEADS, HG_V))
        mixed = jnp.concatenate([y_a, o_b.reshape(bsz, seqlen, HG_VDIM)], axis=-1).astype(x.dtype)
        x = x + mixed @ w_out[l]
        h = rmsnorm(x, norm_xa_w[l])
        m = rmsnorm(mem, norm_mem_w[l])
        qx = (h @ xa_wq[l]).reshape(bsz, seqlen, XA_HEADS, XA_HEAD_DIM)
        km, vm = jnp.split(m @ xa_wkv[l], 2, axis=-1)
        km = km.reshape(bsz, MEM_LEN, XA_HEADS, XA_HEAD_DIM)
        vm = vm.reshape(bsz, MEM_LEN, XA_HEADS, XA_HEAD_DIM)
        sc = jnp.einsum("bqhd,bkhd->bhqk", qx, km, preferred_element_type=jnp.float32)
        pr = jax.nn.softmax(sc * (XA_HEAD_DIM ** -0.5), axis=-1).astype(vm.dtype)
        ox = jnp.einsum("bhqk,bkhd->bqhd", pr, vm).reshape(bsz, seqlen, D_MODEL)
        x = x + ox @ xa_wo[l]
        h = rmsnorm(x, norm_ffn_w[l])
        x = x + (jax.nn.silu(h @ ffn_w_gate[l]) * (h @ ffn_w_up[l])) @ ffn_w_down[l]
    return rmsnorm(x, norm_final_w)
```

```cpp
#include <hip/hip_runtime.h>
#include <cstdio>
#include <cstdint>

#define GAS __attribute__((address_space(1)))
#define LAS __attribute__((address_space(3)))
typedef unsigned short bf16;
typedef unsigned v4u __attribute__((ext_vector_type(4)));
typedef unsigned v2u __attribute__((ext_vector_type(2)));
typedef float f32x4 __attribute__((ext_vector_type(4)));
typedef float f32x2 __attribute__((ext_vector_type(2)));
typedef short bf16x8 __attribute__((ext_vector_type(8)));
typedef GAS unsigned gu32;

constexpr int BATCH = 2, SEQ = 16384, D = 1024, T = BATCH * SEQ;
constexpr int MEMLEN = 256, NIN = 6672, FF = 2816;
constexpr float EPS = 1e-6f;
constexpr int PJ = 6656;
constexpr int C_Z = 0, C_G = 1024, C_X = 2048, C_B = 3072, C_C = 3328, C_Q = 3584, C_F = 4608, C_I = 5632;
constexpr int C_X1B = 2048, C_QA = 3072, C_OX = 4096, C_X2B = 5120, C_ACT = 0;

constexpr size_t MiB = 1u << 20;
constexpr size_t WS_CTL = 0, CTL_ZERO_BYTES = 1 * MiB;
constexpr int CW_BAR = 4096;
constexpr int CW_SSQ1 = 32768, CW_SSQ2 = CW_SSQ1 + T, CW_SSQ3 = CW_SSQ2 + T;
static_assert((size_t)(CW_SSQ3 + T) * 4 <= CTL_ZERO_BYTES, "ctl");
constexpr size_t WS_RSTD0 = 1 * MiB;
constexpr size_t WS_DT = 2 * MiB;
constexpr size_t WS_KM = 4 * MiB;
constexpr size_t WS_VT = 5 * MiB;
constexpr size_t WS_WIN = 16 * MiB;
constexpr size_t WS_WOUT = 29 * MiB;
constexpr size_t WS_WQ = 33 * MiB;
constexpr size_t WS_WO = 35 * MiB;
constexpr size_t WS_WGU = 37 * MiB;
constexpr size_t WS_WD = 48 * MiB;
constexpr size_t WS_PROJ = 56 * MiB;
constexpr size_t WS_END = WS_PROJ + (size_t)T * PJ * 2;
static_assert(WS_END <= 512 * MiB, "ws");

constexpr int NWAVES = 8;
constexpr int RING_OFF = 0, RING_BYTES = 131072;
constexpr int LDSCTL_OFF = RING_BYTES, MISC_OFF = LDSCTL_OFF + 320;
constexpr int LDS_BYTES = 147456;

#define RLX_AGENT __ATOMIC_RELAXED, __HIP_MEMORY_SCOPE_AGENT
#define LDS_WAIT() asm volatile("s_waitcnt lgkmcnt(0)" ::: "memory")
#define VM_WAIT() asm volatile("s_waitcnt vmcnt(0)" ::: "memory")
__device__ __forceinline__ unsigned f2bf(float f) { unsigned u = __builtin_bit_cast(unsigned, f); return (u + 0x7fffu + ((u >> 16) & 1u)) >> 16; }
__device__ __forceinline__ unsigned pk2(float lo, float hi) { return f2bf(lo) | (f2bf(hi) << 16); }
__device__ __forceinline__ float bf2f(unsigned b) { return __builtin_bit_cast(float, b << 16); }
__device__ __forceinline__ float bflo(unsigned w) { return __builtin_bit_cast(float, w << 16); }
__device__ __forceinline__ float bfhi(unsigned w) { return __builtin_bit_cast(float, w & 0xffff0000u); }
__device__ __forceinline__ float sigmoidf_(float x) { return 1.f / (1.f + __expf(-x)); }
__device__ __forceinline__ float siluf_(float x) { return x / (1.f + __expf(-x)); }
__device__ __forceinline__ float softplusf_(float x) { return x > 20.f ? x : log1pf(__expf(x)); }
__device__ __forceinline__ float wave_sum(float v) {
#pragma unroll
    for (int o = 1; o < 64; o <<= 1) v += __shfl_xor(v, o);
    return v;
}
__device__ __forceinline__ float wave_max(float v) {
#pragma unroll
    for (int o = 1; o < 64; o <<= 1) v = fmaxf(v, __shfl_xor(v, o));
    return v;
}

#define XB_TMO      128
#define XB_XCNT(j)  (256  + 64 * (j))
#define XB_XSUB(j)  (1280 + 64 * (j))
#define XB_XGEN(j)  (2304 + 64 * (j))
#define XB_TOP      3328
#define XB_TOPGEN   3392
#define XCD_BAR_WORDS 3456
#define XB_SPIN_CAP (1u << 22)
__device__ __forceinline__ unsigned xb_ld(unsigned* p)              { return __hip_atomic_load(p, __ATOMIC_RELAXED, __HIP_MEMORY_SCOPE_AGENT); }
__device__ __forceinline__ unsigned xb_add(unsigned* p, unsigned v) { return __hip_atomic_fetch_add(p, v, __ATOMIC_RELAXED, __HIP_MEMORY_SCOPE_AGENT); }
__device__ __forceinline__ unsigned xb_xcc_id() { return (unsigned)__builtin_amdgcn_s_getreg((3 << 11) | 20) & 0xFu; }
#define XB_SPIN(cond, bar) do { unsigned _sp = 0; while (cond) { __builtin_amdgcn_s_sleep(1); \
    if ((++_sp & 255u) == 0u) { if (xb_ld(&(bar)[XB_TMO])) break; if (_sp > XB_SPIN_CAP) { atomicAdd(&(bar)[XB_TMO], 1u); break; } } } } while (0)
struct XcdBarrier { unsigned* bar; unsigned x; volatile LAS unsigned* st; };
__device__ __forceinline__ XcdBarrier xcd_barrier_post(unsigned* bar, volatile LAS unsigned* st) {
    XcdBarrier b; b.bar = bar; b.x = xb_xcc_id(); b.st = st;
    if (threadIdx.x == 0) (void)xb_add(&bar[XB_XCNT(b.x)], 1u);
    return b;
}
__device__ __forceinline__ void xcd_barrier_complete(unsigned* bar, unsigned x, unsigned& nloc, unsigned& nx) {
    const unsigned G = gridDim.x * gridDim.y * gridDim.z;
    unsigned sum, cnt, mine, sp = 0u;
    for (;;) {
        sum = 0u; cnt = 0u; mine = 0u;
#pragma unroll
        for (unsigned j = 0; j < 16; ++j) { const unsigned c = xb_ld(&bar[XB_XCNT(j)]); sum += c; cnt += (c > 0u) ? 1u : 0u; mine = (j == x) ? c : mine; }
        if (sum == G) break;
        __builtin_amdgcn_s_sleep(1);
        if ((++sp & 255u) == 0u) { if (xb_ld(&bar[XB_TMO])) break; if (sp > XB_SPIN_CAP) { atomicAdd(&bar[XB_TMO], 1u); break; } }
    }
    nloc = mine > 0u ? mine : 1u; nx = cnt > 0u ? cnt : 1u;
}
__device__ __forceinline__ void xcd_barrier(const XcdBarrier& b) {
    asm volatile("s_waitcnt vmcnt(0)" ::: "memory");
    __syncthreads();
    if (threadIdx.x == 0) {
        unsigned* bar = b.bar;
        __builtin_amdgcn_s_waitcnt(0);
        unsigned nloc = b.st[0], nx = b.st[1];
        if (nloc == 0u) { xcd_barrier_complete(bar, b.x, nloc, nx); b.st[0] = nloc; b.st[1] = nx; }
        const unsigned old = xb_add(&bar[XB_XSUB(b.x)], 1u);
        const unsigned gen = old / nloc;
        if (old + 1u == (gen + 1u) * nloc) {
            __builtin_amdgcn_fence(__ATOMIC_RELEASE, "agent");
            asm volatile("s_waitcnt vmcnt(0)" ::: "memory");
            const unsigned og = xb_add(&bar[XB_TOP], 1u);
            const unsigned tg = og / nx;
            if (og + 1u == (tg + 1u) * nx) xb_add(&bar[XB_TOPGEN], 1u);
            else XB_SPIN(xb_ld(&bar[XB_TOPGEN]) == tg, bar);
            __builtin_amdgcn_fence(__ATOMIC_ACQUIRE, "agent");
            xb_add(&bar[XB_XGEN(b.x)], 1u);
            asm volatile("s_waitcnt vmcnt(0)" ::: "memory");
        } else {
            XB_SPIN(xb_ld(&bar[XB_XGEN(b.x)]) == gen, bar);
            __builtin_amdgcn_fence(__ATOMIC_ACQUIRE, "agent");
            asm volatile("s_waitcnt vmcnt(0)" ::: "memory");
        }
    }
    __syncthreads();
}

namespace pg8 {
#define PG8_LAS __attribute__((address_space(3)))
typedef unsigned short bf16_t;
typedef unsigned u32x4 __attribute__((ext_vector_type(4)));
constexpr int BM = 256, BK = 64, HALF = 128, HTB = HALF * BK * 2, STAGE_BYTES = 8 * HTB, NXCD = 8, WGM = 8;
__host__ __device__ __forceinline__ int lds_byte(int r, int c) { const int st = (r >> 4) * 2 + (c >> 5), rr = r & 15, cc = c & 31, ob = rr * 64 + cc * 2; return st * 1024 + (ob ^ (((ob >> 9) & 1) << 5)); }
__host__ __device__ __forceinline__ void stage_rc(int b, int& R, int& C) { const int st = b / 1024, sb = b % 1024, swz = sb ^ (((sb >> 9) & 1) << 5); R = (st >> 1) * 16 + swz / 64; C = (st & 1) * 32 + (swz % 64) / 2; }
__host__ __device__ __forceinline__ int perm32(int rho) { const int n = rho >> 4, i = rho & 15; return 8 * (i >> 2) + 4 * n + (i & 3); }
struct Unit { int pm, pn; };
struct Gemm { const bf16_t* A; int lda; const bf16_t* Bt; int M, N, K; };
struct StaticOrder {
    int nM, nN, nwg, G, c;
    __host__ __device__ void init(int M, int N, int G_, int c_) { nM = M / BM; nN = N / BM; nwg = nM * nN; G = G_; c = c_; }
    __host__ __device__ bool next(int i, Unit& u) const {
        const long L = (long)i * G + c; if (L >= nwg) return false;
        int wgid = (int)L; { const int q = nwg / NXCD, r = nwg % NXCD, xcd = wgid % NXCD, off = wgid / NXCD; wgid = (xcd < r ? xcd * (q + 1) : r * (q + 1) + (xcd - r) * q) + off; }
        const int nig = WGM * nN, gid = wgid / nig, fm = gid * WGM, gsz = (nM - fm) < WGM ? (nM - fm) : WGM;
        u.pm = fm + ((wgid % nig) % gsz); u.pn = (wgid % nig) / gsz; return true;
    }
    __device__ __forceinline__ void a_ready(const Unit&) const {}
    __device__ __forceinline__ void done(const Unit&) const {}
};
__device__ __forceinline__ unsigned cvt_pk_bf16(float lo, float hi) { unsigned r; asm volatile("v_cvt_pk_bf16_f32 %0, %1, %2" : "=v"(r) : "v"(lo), "v"(hi)); return r; }

template <int MODE> struct EpiScaleBf16 {
    static constexpr bool PERM = true, AFTER_DRAIN = false;
    bf16_t* O; int ldc; const float* rs;
    __device__ __forceinline__ void operator()(const f32x4 (&acc)[2][2][4][2], const Unit& u, int wr, int wc, int fr, int fq) const {
        const int row0 = u.pm * BM + wr * 64 + fr; const int col0 = u.pn * BM + wc * 32 + 8 * fq;
#pragma unroll
        for (int ai = 0; ai < 2; ++ai)
#pragma unroll
            for (int m = 0; m < 4; ++m) { const int row = row0 + ai * HALF + m * 16; float sc = rs[row]; if (MODE == 1) sc = 1.0f / sqrtf(sc * (1.0f / 1024.0f) + 1e-6f);
                bf16_t* rowp = O + (size_t)row * ldc + col0;
#pragma unroll
                for (int bj = 0; bj < 2; ++bj) { const f32x4 v0 = acc[ai][bj][m][0] * sc, v1 = acc[ai][bj][m][1] * sc; u32x4 w;
                    w.x = cvt_pk_bf16(v0[0], v0[1]); w.y = cvt_pk_bf16(v0[2], v0[3]); w.z = cvt_pk_bf16(v1[0], v1[1]); w.w = cvt_pk_bf16(v1[2], v1[3]);
                    *(u32x4*)(rowp + bj * HALF) = w; } }
    }
};
struct EpiSwiglu {
    static constexpr bool PERM = true, AFTER_DRAIN = false;
    bf16_t* O; int ldc; const float* ssq;
    __device__ __forceinline__ void operator()(const f32x4 (&acc)[2][2][4][2], const Unit& u, int wr, int wc, int fr, int fq) const {
        const int row0 = u.pm * BM + wr * 64 + fr; const int col0 = u.pn * HALF + wc * 32 + 8 * fq;
#pragma unroll
        for (int ai = 0; ai < 2; ++ai)
#pragma unroll
            for (int m = 0; m < 4; ++m) { const int row = row0 + ai * HALF + m * 16; const float sc = 1.0f / sqrtf(ssq[row] * (1.0f / 1024.0f) + 1e-6f);
                float o[8];
#pragma unroll
                for (int n = 0; n < 2; ++n)
#pragma unroll
                    for (int i = 0; i < 4; ++i) { const float g = acc[ai][0][m][n][i] * sc, up = acc[ai][1][m][n][i] * sc; o[n * 4 + i] = g / (1.0f + __expf(-g)) * up; }
                u32x4 w; w.x = cvt_pk_bf16(o[0], o[1]); w.y = cvt_pk_bf16(o[2], o[3]); w.z = cvt_pk_bf16(o[4], o[5]); w.w = cvt_pk_bf16(o[6], o[7]);
                *(u32x4*)(O + (size_t)row * ldc + col0) = w; }
    }
};
struct EpiRes {
    static constexpr bool PERM = false, AFTER_DRAIN = false;
    const float* xold; float* xnew; bf16_t* XB; int ldb; float* ssq;
    __device__ __forceinline__ void operator()(const f32x4 (&acc)[2][2][4][2], const Unit& u, int wr, int wc, int fr, int fq) const {
        const int row0 = u.pm * BM + wr * 64 + fr; const int col0 = u.pn * BM + wc * 32 + 4 * fq;
#pragma unroll
        for (int ai = 0; ai < 2; ++ai)
#pragma unroll
            for (int m = 0; m < 4; ++m) { const int row = row0 + ai * HALF + m * 16; const size_t off = (size_t)row * 1024 + col0; float s = 0.f;
#pragma unroll
                for (int bj = 0; bj < 2; ++bj)
#pragma unroll
                    for (int n = 0; n < 2; ++n) { const f32x4 xo = *(const f32x4*)(xold + off + bj * HALF + n * 16); const f32x4 xn = xo + acc[ai][bj][m][n];
                        *(f32x4*)(xnew + off + bj * HALF + n * 16) = xn; s += (xn[0] * xn[0] + xn[1] * xn[1]) + (xn[2] * xn[2] + xn[3] * xn[3]);
                        v2u w; w.x = cvt_pk_bf16(xn[0], xn[1]); w.y = cvt_pk_bf16(xn[2], xn[3]);
                        *(v2u*)(XB + (size_t)row * ldb + col0 + bj * HALF + n * 16) = w; }
                s += __shfl_xor(s, 16); s += __shfl_xor(s, 32);
                if (fq == 0) atomicAdd(ssq + row, s);
                if (m & 1) asm volatile("" ::: "memory"); }
    }
};

template <class Epi, class Sched, bool ALIGN_EPI = false, bool SP2 = false>
__device__ __forceinline__ void gemm_phase(PG8_LAS unsigned char* lds, const Gemm g, const Sched& S, const Epi& E) {
    const int tid = threadIdx.x, wid = __builtin_amdgcn_readfirstlane(tid >> 6), lane = tid & 63, wr = wid >> 2, wc = wid & 3, fr = lane & 15, fq = lane >> 4;
    const int K = g.K, nt = K / BK, lda = g.lda;
    unsigned voffA[2], voffB[2];
#pragma unroll
    for (int i = 0; i < 2; ++i) { int R, C; stage_rc(tid * 16 + i * 8192, R, C); const int Rb = Epi::PERM ? ((R & ~31) + perm32(R & 31)) : R;
        voffA[i] = (unsigned)(R * lda + C) * 2u; voffB[i] = (unsigned)(Rb * K + C) * 2u; }
    const size_t kstep = (size_t)(BK * 2);
    const size_t hstepA = (size_t)HALF * lda * 2, hstepB = (size_t)HALF * K * 2;
    const size_t tstepA = 2 * hstepA, tstepB = 2 * hstepB;
    const unsigned ldsw = (unsigned)wid * 1024u;
    const int aoff = lds_byte(wr * 64 + fr, fq * 8), boff = lds_byte(wc * 32 + fr, fq * 8);
#define PG8_SA(b, h) (((b) * 2 + (h)) * HTB)
#define PG8_SB(b, h) ((4 + (b) * 2 + (h)) * HTB)
#define PG8_STAGE(bufoff, gbase, voff) do { _Pragma("unroll") for (int _i = 0; _i < 2; ++_i) \
        __builtin_amdgcn_global_load_lds((const unsigned*)((const char*)(gbase) + (voff)[_i]), (PG8_LAS unsigned*)(lds + (bufoff) + ldsw + _i * 8192), 16, 0, 0); } while (0)
#define PG8_LDA(dst, b, h) do { _Pragma("unroll") for (int m = 0; m < 4; ++m) _Pragma("unroll") for (int k = 0; k < 2; ++k) dst[m][k] = *(const PG8_LAS bf16x8*)(lds + PG8_SA(b, h) + aoff + m * 2048 + k * 1024); } while (0)
#define PG8_LDB(dst, b, h) do { _Pragma("unroll") for (int n = 0; n < 2; ++n) _Pragma("unroll") for (int k = 0; k < 2; ++k) dst[n][k] = *(const PG8_LAS bf16x8*)(lds + PG8_SB(b, h) + boff + n * 2048 + k * 1024); } while (0)
#define PG8_MMA(ai, bj, At, Bt) do { __builtin_amdgcn_s_setprio(1); _Pragma("unroll") for (int m = 0; m < 4; ++m) _Pragma("unroll") for (int n = 0; n < 2; ++n) _Pragma("unroll") for (int k = 0; k < 2; ++k) \
        acc[ai][bj][m][n] = __builtin_amdgcn_mfma_f32_16x16x32_bf16(Bt[n][k], At[m][k], acc[ai][bj][m][n], 0, 0, 0); __builtin_amdgcn_s_setprio(0); } while (0)
#define PG8_WAIT_V(n) asm volatile("s_waitcnt vmcnt(" #n ")" ::: "memory")
#define PG8_WAIT_L(n) asm volatile("s_waitcnt lgkmcnt(" #n ")" ::: "memory")
#define PG8_BAR __builtin_amdgcn_s_barrier()
#define PG8_SCHED __builtin_amdgcn_sched_barrier(0)
    Unit cur, nxt; int ui = 0;
    if (!S.next(0, cur)) return;
    f32x4 acc[2][2][4][2];
#pragma unroll
    for (int a = 0; a < 2; ++a)
#pragma unroll
        for (int b = 0; b < 2; ++b)
#pragma unroll
            for (int m = 0; m < 4; ++m)
#pragma unroll
                for (int n = 0; n < 2; ++n) acc[a][b][m][n] = (f32x4){0.f, 0.f, 0.f, 0.f};
    bf16x8 At[4][2], B0[2][2], B1[2][2];
    const char* cA = (const char*)g.A + (size_t)cur.pm * tstepA; const char* cB = (const char*)g.Bt + (size_t)cur.pn * tstepB;
    S.a_ready(cur);
    if constexpr (SP2) {
        PG8_STAGE(PG8_SB(0, 0), cB, voffB); PG8_STAGE(PG8_SB(0, 1), cB + hstepB, voffB); PG8_STAGE(PG8_SA(0, 0), cA, voffA); PG8_STAGE(PG8_SA(0, 1), cA + hstepA, voffA);
        if (wr == 1) PG8_BAR;
        PG8_WAIT_V(2); PG8_BAR;
        PG8_STAGE(PG8_SB(1, 0), cB + kstep, voffB); PG8_STAGE(PG8_SA(1, 0), cA + kstep, voffA); PG8_STAGE(PG8_SB(1, 1), cB + hstepB + kstep, voffB);
        PG8_WAIT_V(6); PG8_BAR;
    } else {
        PG8_STAGE(PG8_SB(0, 0), cB, voffB); PG8_STAGE(PG8_SA(0, 0), cA, voffA); PG8_STAGE(PG8_SB(0, 1), cB + hstepB, voffB); PG8_STAGE(PG8_SA(0, 1), cA + hstepA, voffA);
        if (wr == 1) PG8_BAR;
        PG8_WAIT_V(4); PG8_BAR;
        PG8_STAGE(PG8_SB(1, 0), cB + kstep, voffB); PG8_STAGE(PG8_SA(1, 0), cA + kstep, voffA); PG8_STAGE(PG8_SB(1, 1), cB + hstepB + kstep, voffB);
        PG8_WAIT_V(6); PG8_BAR;
    }
    for (;;) {
        const bool has_next = S.next(ui + 1, nxt);
        const char* nA = has_next ? (const char*)g.A + (size_t)nxt.pm * tstepA : cA; const char* nB = has_next ? (const char*)g.Bt + (size_t)nxt.pn * tstepB : cB;
        for (int t = 0; t < nt; t += 2) {
            const bool last = (t == nt - 2);
            const char* a1 = cA + (size_t)(t + 1) * kstep;
            const char* a2 = last ? nA : cA + (size_t)(t + 2) * kstep; const char* b2 = last ? nB : cB + (size_t)(t + 2) * kstep;
            const char* a3 = a2 + kstep; const char* b3 = b2 + kstep;
            if (last && has_next) S.a_ready(nxt);
            if constexpr (SP2) {
            PG8_LDB(B0, 0, 0); PG8_LDB(B1, 0, 1); PG8_SCHED; PG8_LDA(At, 0, 0); PG8_STAGE(PG8_SA(1, 1), a1 + hstepA, voffA);
            PG8_WAIT_V(8); PG8_WAIT_L(0); PG8_BAR; PG8_MMA(0, 0, At, B0); PG8_MMA(0, 1, At, B1); PG8_BAR; PG8_SCHED;
            PG8_LDA(At, 0, 1); PG8_STAGE(PG8_SB(0, 0), b2, voffB); PG8_STAGE(PG8_SB(0, 1), b2 + hstepB, voffB); PG8_STAGE(PG8_SA(0, 0), a2, voffA);
            PG8_WAIT_V(8); PG8_WAIT_L(0); PG8_BAR; PG8_MMA(1, 0, At, B0); PG8_MMA(1, 1, At, B1); PG8_BAR; PG8_SCHED;
            PG8_LDB(B0, 1, 0); PG8_LDB(B1, 1, 1); PG8_SCHED; PG8_LDA(At, 1, 0); PG8_STAGE(PG8_SA(0, 1), a2 + hstepA, voffA);
            PG8_WAIT_V(8); PG8_WAIT_L(0); PG8_BAR; PG8_MMA(0, 0, At, B0); PG8_MMA(0, 1, At, B1); PG8_BAR; PG8_SCHED;
            PG8_LDA(At, 1, 1); PG8_STAGE(PG8_SB(1, 0), b3, voffB); PG8_STAGE(PG8_SB(1, 1), b3 + hstepB, voffB); PG8_STAGE(PG8_SA(1, 0), a3, voffA);
            PG8_WAIT_V(8); PG8_WAIT_L(0); PG8_BAR; PG8_MMA(1, 0, At, B0); PG8_MMA(1, 1, At, B1); PG8_BAR; PG8_SCHED;
            } else {
            PG8_LDB(B0, 0, 0); PG8_SCHED; PG8_LDA(At, 0, 0); PG8_STAGE(PG8_SA(1, 1), a1 + hstepA, voffA);
            PG8_WAIT_L(8); PG8_BAR; PG8_WAIT_L(0); PG8_MMA(0, 0, At, B0); PG8_BAR; PG8_SCHED;
            PG8_LDB(B1, 0, 1); PG8_STAGE(PG8_SB(0, 0), b2, voffB);
            PG8_BAR; PG8_WAIT_L(0); PG8_MMA(0, 1, At, B1); PG8_BAR;
            PG8_LDA(At, 0, 1); PG8_STAGE(PG8_SA(0, 0), a2, voffA);
            PG8_BAR; PG8_WAIT_L(0); PG8_MMA(1, 0, At, B0); PG8_BAR; PG8_SCHED;
            PG8_STAGE(PG8_SB(0, 1), b2 + hstepB, voffB);
            PG8_WAIT_V(6); PG8_BAR; PG8_MMA(1, 1, At, B1); PG8_BAR;
            PG8_LDB(B0, 1, 0); PG8_SCHED; PG8_LDA(At, 1, 0); PG8_STAGE(PG8_SA(0, 1), a2 + hstepA, voffA);
            PG8_WAIT_L(8); PG8_BAR; PG8_WAIT_L(0); PG8_MMA(0, 0, At, B0); PG8_BAR; PG8_SCHED;
            PG8_LDB(B1, 1, 1); PG8_STAGE(PG8_SB(1, 0), b3, voffB);
            PG8_BAR; PG8_WAIT_L(0); PG8_MMA(0, 1, At, B1); PG8_BAR;
            PG8_LDA(At, 1, 1); PG8_STAGE(PG8_SA(1, 0), a3, voffA);
            PG8_BAR; PG8_WAIT_L(0); PG8_MMA(1, 0, At, B0); PG8_BAR; PG8_SCHED;
            PG8_STAGE(PG8_SB(1, 1), b3 + hstepB, voffB);
            PG8_WAIT_V(6); PG8_BAR; PG8_MMA(1, 1, At, B1); PG8_BAR;
            }
        }
        if constexpr (ALIGN_EPI) { if (wr == 0) PG8_BAR; }
        if constexpr (!Epi::AFTER_DRAIN) { E(acc, cur, wr, wc, fr, fq); S.done(cur); }
        if (!has_next) break;
#pragma unroll
        for (int a = 0; a < 2; ++a)
#pragma unroll
            for (int b = 0; b < 2; ++b)
#pragma unroll
                for (int m = 0; m < 4; ++m)
#pragma unroll
                    for (int n = 0; n < 2; ++n) acc[a][b][m][n] = (f32x4){0.f, 0.f, 0.f, 0.f};
        cur = nxt; cA = nA; cB = nB; ++ui;
        if constexpr (ALIGN_EPI) { if (wr == 1) PG8_BAR; }
    }
    PG8_WAIT_V(0);
    if constexpr (!ALIGN_EPI) { if (wr == 0) PG8_BAR; }
    PG8_BAR;
#undef PG8_SA
#undef PG8_SB
#undef PG8_STAGE
#undef PG8_LDA
#undef PG8_LDB
#undef PG8_MMA
#undef PG8_WAIT_V
#undef PG8_WAIT_L
#undef PG8_BAR
#undef PG8_SCHED
}
}

struct Args { const float* in[23]; float* out; unsigned char* ws; };
struct Frame {
    LAS unsigned char* lds;
    int tid, lane, wave, G, bid;
};

__device__ __forceinline__ void p0_transpose_item(const float* W, int ldw, int col0, int K, bf16* WT, int dst_row0, int k0, const float* ks, float mul, LAS float* scr, int lane) {
#pragma unroll 8
    for (int i = 0; i < 32; ++i) { const int kk = 2 * i + (lane >> 5); float v = W[(size_t)(k0 + kk) * ldw + col0 + (lane & 31)]; if (ks) v *= ks[kk]; scr[kk * 33 + (lane & 31)] = v * mul; }
    LDS_WAIT(); asm volatile("" ::: "memory");
    const int c = lane & 7;
#pragma unroll
    for (int j = 0; j < 4; ++j) { const int n = (lane >> 3) + 8 * j; const LAS float* s = scr + (8 * c) * 33 + n;
        v4u o; o.x = pk2(s[0 * 33], s[1 * 33]); o.y = pk2(s[2 * 33], s[3 * 33]); o.z = pk2(s[4 * 33], s[5 * 33]); o.w = pk2(s[6 * 33], s[7 * 33]);
        *(v4u*)(WT + (size_t)(dst_row0 + n) * K + k0 + 8 * c) = o; }
    LDS_WAIT(); asm volatile("" ::: "memory");
}

__device__ __forceinline__ void p0_prologue(const Frame& F, const Args& a) {
    unsigned char* ws = a.ws;
    const int gw = F.bid * NWAVES + F.wave, NGW = F.G * NWAVES;
    {
        LAS float* scr = (LAS float*)(F.lds + F.wave * 8704);
        bf16* WinT = (bf16*)(ws + WS_WIN); bf16* WoutT = (bf16*)(ws + WS_WOUT); bf16* WqT = (bf16*)(ws + WS_WQ); bf16* WoT = (bf16*)(ws + WS_WO); bf16* WguT = (bf16*)(ws + WS_WGU); bf16* WdT = (bf16*)(ws + WS_WD);
        constexpr int I_IN = 16 * (PJ / 32);
        constexpr int I_OUT = 32 * 32, I_Q = 16 * 32, I_O = 16 * 32, I_G = 16 * 88, I_U = 16 * 88, I_D = 44 * 32;
        constexpr int NITEMS = I_IN + I_OUT + I_Q + I_O + I_G + I_U + I_D;
        for (int it = gw; it < NITEMS; it += NGW) {
            int r = it;
            if (r < I_IN) { const int nblk = PJ / 32, kb = r / nblk, nb = r % nblk, drow = nb * 32;
                int scol;
                if (drow < 1024) scol = drow;
                else if (drow < 2048) scol = 5648 + (drow - 1024);
                else if (drow < 3584) scol = 1024 + (drow - 2048);
                else if (drow < 4608) scol = 2576 + (drow - 3584);
                else if (drow < 5632) scol = 3600 + (drow - 4608);
                else scol = 4624 + (drow - 5632);
                p0_transpose_item(a.in[3], NIN, scol, 1024, WinT, drow, kb * 64, a.in[2] + kb * 64, 1.f, scr, F.lane); continue; }
            r -= I_IN;
            if (r < I_OUT) { const int kb = r / 32, nb = r % 32, k0 = kb * 64; const float* ks = (k0 < 1024) ? a.in[9] + k0 : a.in[11] + ((k0 - 1024) & 127);
                p0_transpose_item(a.in[12], 1024, nb * 32, 2048, WoutT, nb * 32, k0, ks, 1.f, scr, F.lane); continue; }
            r -= I_OUT;
            if (r < I_Q) { const int kb = r / 32, nb = r % 32; p0_transpose_item(a.in[15], 1024, nb * 32, 1024, WqT, nb * 32, kb * 64, a.in[13] + kb * 64, 0.0625f, scr, F.lane); continue; }
            r -= I_Q;
            if (r < I_O) { const int kb = r / 32, nb = r % 32; p0_transpose_item(a.in[17], 1024, nb * 32, 1024, WoT, nb * 32, kb * 64, nullptr, 1.f, scr, F.lane); continue; }
            r -= I_O;
            if (r < I_G) { const int kb = r / 88, nb = r % 88, c0 = nb * 32; p0_transpose_item(a.in[19], FF, c0, 1024, WguT, (c0 >> 7) * 256 + (c0 & 127), kb * 64, a.in[18] + kb * 64, 1.f, scr, F.lane); continue; }
            r -= I_G;
            if (r < I_U) { const int kb = r / 88, nb = r % 88, c0 = nb * 32; p0_transpose_item(a.in[20], FF, c0, 1024, WguT, (c0 >> 7) * 256 + 128 + (c0 & 127), kb * 64, a.in[18] + kb * 64, 1.f, scr, F.lane); continue; }
            r -= I_U;
            { const int kb = r / 32, nb = r % 32; p0_transpose_item(a.in[21], 1024, nb * 32, FF, WdT, nb * 32, kb * 64, nullptr, 1.f, scr, F.lane); }
        }
    }
    __syncthreads();
    LAS float* wdt = (LAS float*)(F.lds);
    for (int i = F.tid; i < 16 * 1024; i += NWAVES * 64) { const int k = i >> 4, c = i & 15; wdt[c * 1024 + k] = a.in[3][(size_t)k * NIN + 2560 + c] * a.in[2][k]; }
    __syncthreads();
    {
        bf16* XB = (bf16*)a.out; float* rstd0 = (float*)(ws + WS_RSTD0); float* dtb = (float*)(ws + WS_DT);
        for (int m = gw; m < T; m += NGW) {
            const f32x4* xr = (const f32x4*)(a.in[0] + (size_t)m * D) + F.lane;
            f32x4 v[4]; float s = 0.f;
#pragma unroll
            for (int j = 0; j < 4; ++j) { v[j] = xr[64 * j]; s += (v[j].x * v[j].x + v[j].y * v[j].y) + (v[j].z * v[j].z + v[j].w * v[j].w); }
            const float rstd = 1.0f / sqrtf(wave_sum(s) * (1.f / D) + EPS);
            unsigned long long* o8 = (unsigned long long*)(XB + (size_t)m * D) + F.lane;
#pragma unroll
            for (int j = 0; j < 4; ++j) o8[64 * j] = (unsigned long long)pk2(v[j].x, v[j].y) | ((unsigned long long)pk2(v[j].z, v[j].w) << 32);
            float mydt = 0.f;
#pragma unroll 1
            for (int c = 0; c < 16; ++c) { float d = 0.f;
#pragma unroll
                for (int j = 0; j < 4; ++j) { const f32x4 w = *(const LAS f32x4*)(wdt + c * 1024 + 256 * j + 4 * F.lane); d += (v[j].x * w.x + v[j].y * w.y) + (v[j].z * w.z + v[j].w * w.w); }
                d = wave_sum(d); if (F.lane == c) mydt = d; }
            if (F.lane == 0) rstd0[m] = rstd;
            if (F.lane < 16) dtb[(size_t)m * 16 + F.lane] = softplusf_(mydt * rstd + a.in[6][F.lane]);
        }
    }
    {
        bf16* KM = (bf16*)(ws + WS_KM); bf16* VT = (bf16*)(ws + WS_VT);
        for (int gt = F.bid * (NWAVES * 64) + F.tid; gt < 64 * 2048; gt += F.G * NWAVES * 64) {
            const int n = gt & 2047, mg = gt >> 11;
            const float* mem = a.in[1] + (size_t)mg * 8 * D; const float* wkv = a.in[16] + n; const float* nw = a.in[14];
            float acc[8], ss[8];
#pragma unroll
            for (int i = 0; i < 8; ++i) { acc[i] = 0.f; ss[i] = 0.f; }
            for (int k = 0; k < D; ++k) { const float w = wkv[(size_t)k * 2048] * nw[k];
#pragma unroll
                for (int i = 0; i < 8; ++i) { const float xv = mem[i * D + k]; acc[i] += xv * w; ss[i] += xv * xv; } }
#pragma unroll
            for (int i = 0; i < 8; ++i) { const int m = mg * 8 + i, b = m >> 8, key = m & 255; const float v = acc[i] / sqrtf(ss[i] * (1.f / D) + EPS);
                if (n < 1024) { const int h = n >> 8, d = n & 255; KM[(((size_t)b * 4 + h) * 256 + key) * 256 + d] = (bf16)f2bf(v); }
                else { const int h = (n - 1024) >> 8, d = n & 255; VT[(((size_t)b * 4 + h) * 256 + d) * 256 + key] = (bf16)f2bf(v); } }
        }
    }
}

__device__ __forceinline__ void s_conv(const Frame& F, const Args& a, const bf16* proj, bf16* XC) {
    const float* cw = a.in[4]; const float* cb = a.in[5];
    const size_t total = (size_t)T * 1536;
    for (size_t i = (size_t)F.bid * (NWAVES * 64) + F.tid; i < total; i += (size_t)F.G * NWAVES * 64) {
        const int row = (int)(i / 1536), ch = (int)(i % 1536), t = row & (SEQ - 1);
        float acc = cb[ch];
#pragma unroll
        for (int k = 0; k < 4; ++k) { const int tt = t - 3 + k; if (tt >= 0) acc += cw[k * 1536 + ch] * bf2f(proj[(size_t)(row - 3 + k) * PJ + C_X + ch]); }
        XC[i] = (bf16)f2bf(siluf_(acc));
    }
}
__device__ __forceinline__ void s_scan(const Frame& F, const Args& a, bf16* proj, const bf16* XC) {
    const float* dtb = (const float*)(a.ws + WS_DT);
    LAS float* sm = (LAS float*)F.lds;
    if (F.bid < 32) {
        const int b = F.bid >> 4, h = F.bid & 15, g = h >> 3, p = F.tid & 63, nq = F.tid >> 6;
        const float av = -__expf(a.in[7][h]), Dh = a.in[8][h];
        float st[16];
#pragma unroll
        for (int i = 0; i < 16; ++i) st[i] = 0.f;
        for (int t = 0; t < SEQ; ++t) {
            const size_t row = (size_t)b * SEQ + t;
            const float dt = dtb[row * 16 + h], dA = __expf(dt * av);
            const float xv = bf2f(XC[row * 1536 + h * 64 + p]);
            const bf16* Bp = XC + row * 1536 + 1024 + g * 128 + nq * 16; const bf16* Cp = Bp + 256;
            const float dx = dt * xv; float part = 0.f;
#pragma unroll
            for (int i = 0; i < 16; ++i) { st[i] = st[i] * dA + dx * bf2f(Bp[i]); part += st[i] * bf2f(Cp[i]); }
            LAS float* yb = sm + (t & 1) * 512;
            yb[nq * 64 + p] = part;
            __syncthreads();
            if (nq == 0) { float y = Dh * xv;
#pragma unroll
                for (int q = 0; q < 8; ++q) y += yb[q * 64 + p];
                bf16* zp = proj + row * PJ + C_Z + h * 64 + p; const float z = bf2f(*zp); *zp = (bf16)f2bf(y * siluf_(z)); }
        }
    } else if (F.bid < 48) {
        const int bb = F.bid - 32, b = bb >> 3, h = bb & 7, v = F.tid & 127, kq = F.tid >> 7;
        float lbv = 0.f; if (F.tid < 128) lbv = sigmoidf_(a.in[10][h * 128 + F.tid] - a.in[10][1024 + h * 128 + F.tid]);
        float S[32];
#pragma unroll
        for (int i = 0; i < 32; ++i) S[i] = 0.f;
        for (int t = 0; t < SEQ; ++t) {
            const size_t row = (size_t)b * SEQ + t;
            LAS float* fb = sm + 1024 + (t & 1) * 256; LAS float* qb = fb + 128; LAS float* pb = sm + 2048 + (t & 1) * 512;
            if (F.tid < 128) { const float hf = bf2f(proj[row * PJ + C_F + h * 128 + F.tid]), hq = bf2f(proj[row * PJ + C_Q + h * 128 + F.tid]);
                fb[F.tid] = lbv + (1.f - lbv) * sigmoidf_(hf); qb[F.tid] = siluf_(hq); }
            const float iv = bf2f(proj[row * PJ + C_I + h * 128 + v]);
            __syncthreads();
            float part = 0.f;
#pragma unroll
            for (int i = 0; i < 32; ++i) { const float f = fb[kq * 32 + i]; S[i] = f * S[i] + (1.f - f) * iv; part += S[i] * qb[kq * 32 + i]; }
            pb[kq * 128 + v] = part;
            __syncthreads();
            if (kq == 0) { const float o = (pb[v] + pb[128 + v]) + (pb[256 + v] + pb[384 + v]); proj[row * PJ + C_Q + h * 128 + v] = (bf16)f2bf(o); }
        }
    }
}
__device__ __forceinline__ void s_norms(const Frame& F, bf16* proj) {
    const int gw = F.bid * NWAVES + F.wave, NGW = F.G * NWAVES;
    for (int m = gw; m < T; m += NGW) {
        bf16* pr = proj + (size_t)m * PJ;
#pragma unroll
        for (int g = 0; g < 2; ++g) { v4u w = *(const v4u*)(pr + C_Z + g * 512 + 8 * F.lane); float x[8] = {bflo(w.x), bfhi(w.x), bflo(w.y), bfhi(w.y), bflo(w.z), bfhi(w.z), bflo(w.w), bfhi(w.w)};
            float s = 0.f;
#pragma unroll
            for (int i = 0; i < 8; ++i) s += x[i] * x[i];
            const float r = 1.0f / sqrtf(wave_sum(s) * (1.f / 512.f) + EPS);
            v4u o; o.x = pk2(x[0] * r, x[1] * r); o.y = pk2(x[2] * r, x[3] * r); o.z = pk2(x[4] * r, x[5] * r); o.w = pk2(x[6] * r, x[7] * r);
            *(v4u*)(pr + C_Z + g * 512 + 8 * F.lane) = o; }
#pragma unroll
        for (int h = 0; h < 8; ++h) { const unsigned w = *(const unsigned*)(pr + C_Q + h * 128 + 2 * F.lane); const unsigned gt = *(const unsigned*)(pr + C_G + h * 128 + 2 * F.lane);
            const float o0 = bflo(w), o1 = bfhi(w);
            const float r = 1.0f / sqrtf(wave_sum(o0 * o0 + o1 * o1) * (1.f / 128.f) + EPS);
            *(unsigned*)(pr + C_G + h * 128 + 2 * F.lane) = pk2(o0 * r * siluf_(bflo(gt)), o1 * r * siluf_(bfhi(gt))); }
    }
}
__device__ __forceinline__ void s_attn(const Frame& F, const Args& a, bf16* proj) {
    const bf16* KM = (const bf16*)(a.ws + WS_KM); const bf16* VT = (const bf16*)(a.ws + WS_VT);
    LAS float* qs = (LAS float*)F.lds + F.wave * 512; LAS float* ps = qs + 256;
    const int gw = F.bid * NWAVES + F.wave, NGW = F.G * NWAVES;
    for (int it = gw; it < T * 4; it += NGW) {
        const int row = it >> 2, h = it & 3, b = row >> 14;
        { const v2u w = *(const v2u*)(proj + (size_t)row * PJ + C_QA + h * 256 + 4 * F.lane); qs[4 * F.lane] = bflo(w.x); qs[4 * F.lane + 1] = bfhi(w.x); qs[4 * F.lane + 2] = bflo(w.y); qs[4 * F.lane + 3] = bfhi(w.y); }
        LDS_WAIT(); asm volatile("" ::: "memory");
        float s[4];
#pragma unroll
        for (int kk = 0; kk < 4; ++kk) { const bf16* kr = KM + (((size_t)b * 4 + h) * 256 + (F.lane + 64 * kk)) * 256; float acc = 0.f;
            for (int d = 0; d < 256; d += 8) { const v4u w = *(const v4u*)(kr + d);
                acc += qs[d] * bflo(w.x) + qs[d + 1] * bfhi(w.x) + qs[d + 2] * bflo(w.y) + qs[d + 3] * bfhi(w.y) + qs[d + 4] * bflo(w.z) + qs[d + 5] * bfhi(w.z) + qs[d + 6] * bflo(w.w) + qs[d + 7] * bfhi(w.w); }
            s[kk] = acc; }
        const float mx = wave_max(fmaxf(fmaxf(s[0], s[1]), fmaxf(s[2], s[3])));
        float sum = 0.f;
#pragma unroll
        for (int kk = 0; kk < 4; ++kk) { s[kk] = __expf(s[kk] - mx); sum += s[kk]; }
        const float inv = 1.0f / wave_sum(sum);
#pragma unroll
        for (int kk = 0; kk < 4; ++kk) ps[F.lane + 64 * kk] = s[kk] * inv;
        LDS_WAIT(); asm volatile("" ::: "memory");
#pragma unroll
        for (int j = 0; j < 4; ++j) { const int d = F.lane + 64 * j; const bf16* vr = VT + (((size_t)b * 4 + h) * 256 + d) * 256; float acc = 0.f;
            for (int k = 0; k < 256; k += 8) { const v4u w = *(const v4u*)(vr + k);
                acc += ps[k] * bflo(w.x) + ps[k + 1] * bfhi(w.x) + ps[k + 2] * bflo(w.y) + ps[k + 3] * bfhi(w.y) + ps[k + 4] * bflo(w.z) + ps[k + 5] * bfhi(w.z) + ps[k + 6] * bflo(w.w) + ps[k + 7] * bfhi(w.w); }
            proj[(size_t)row * PJ + C_OX + h * 256 + d] = (bf16)f2bf(acc); }
        LDS_WAIT(); asm volatile("" ::: "memory");
    }
}
__device__ __forceinline__ void s_final(const Frame& F, const Args& a, const float* ssq) {
    const int gw = F.bid * NWAVES + F.wave, NGW = F.G * NWAVES;
    for (int m = gw; m < T; m += NGW) {
        const float r = 1.0f / sqrtf(ssq[m] * (1.f / D) + EPS);
        f32x4* xr = (f32x4*)(a.out + (size_t)m * D) + F.lane; const f32x4* wr = (const f32x4*)a.in[22] + F.lane;
#pragma unroll
        for (int j = 0; j < 4; ++j) { f32x4 v = xr[64 * j]; const f32x4 w = wr[64 * j]; v = v * r * w; xr[64 * j] = v; }
    }
}

__global__ void __launch_bounds__(NWAVES * 64, 2) hybrid_fwd(Args args) {
    extern __shared__ __attribute__((aligned(16))) unsigned char lds[];
    Frame F;
    F.lds = (LAS unsigned char*)lds;
    F.tid = threadIdx.x; F.lane = F.tid & 63; F.wave = __builtin_amdgcn_readfirstlane(F.tid >> 6);
    F.G = gridDim.x; F.bid = blockIdx.x;
    unsigned char* ws = args.ws;
    unsigned* ctl = (unsigned*)(ws + WS_CTL);
    for (int u = F.tid; u < (LDS_BYTES - LDSCTL_OFF) / 4; u += NWAVES * 64) ((LAS unsigned*)(F.lds + LDSCTL_OFF))[u] = 0u;
    __syncthreads();
    XcdBarrier bar = xcd_barrier_post(ctl + CW_BAR, (volatile LAS unsigned*)(F.lds + MISC_OFF) + 8);
#define GRID_BAR() xcd_barrier(bar)
    bf16* proj = (bf16*)(ws + WS_PROJ);
    float* ssq1 = (float*)(ctl + CW_SSQ1); float* ssq2 = (float*)(ctl + CW_SSQ2); float* ssq3 = (float*)(ctl + CW_SSQ3);

    p0_prologue(F, args);
    GRID_BAR();
    { pg8::Gemm g{(const bf16*)args.out, D, (const bf16*)(ws + WS_WIN), T, PJ, D}; pg8::StaticOrder S; S.init(T, PJ, F.G, F.bid);
      pg8::EpiScaleBf16<0> E{proj, PJ, (const float*)(ws + WS_RSTD0)};
      pg8::gemm_phase<pg8::EpiScaleBf16<0>, pg8::StaticOrder, true, true>(F.lds + RING_OFF, g, S, E); }
    GRID_BAR();
    s_conv(F, args, proj, (bf16*)args.out);
    GRID_BAR();
    s_scan(F, args, proj, (const bf16*)args.out);
    GRID_BAR();
    s_norms(F, proj);
    GRID_BAR();
    { pg8::Gemm g{proj + C_Z, PJ, (const bf16*)(ws + WS_WOUT), T, D, 2048}; pg8::StaticOrder S; S.init(T, D, F.G, F.bid);
      pg8::EpiRes E{args.in[0], args.out, proj + C_X1B, PJ, ssq1};
      pg8::gemm_phase<pg8::EpiRes, pg8::StaticOrder, true, true>(F.lds + RING_OFF, g, S, E); }
    GRID_BAR();
    { pg8::Gemm g{proj + C_X1B, PJ, (const bf16*)(ws + WS_WQ), T, D, D}; pg8::StaticOrder S; S.init(T, D, F.G, F.bid);
      pg8::EpiScaleBf16<1> E{proj + C_QA, PJ, ssq1};
      pg8::gemm_phase<pg8::EpiScaleBf16<1>, pg8::StaticOrder, true, true>(F.lds + RING_OFF, g, S, E); }
    GRID_BAR();
    s_attn(F, args, proj);
    GRID_BAR();
    { pg8::Gemm g{proj + C_OX, PJ, (const bf16*)(ws + WS_WO), T, D, D}; pg8::StaticOrder S; S.init(T, D, F.G, F.bid);
      pg8::EpiRes E{args.out, args.out, proj + C_X2B, PJ, ssq2};
      pg8::gemm_phase<pg8::EpiRes, pg8::StaticOrder, true, true>(F.lds + RING_OFF, g, S, E); }
    GRID_BAR();
    { pg8::Gemm g{proj + C_X2B, PJ, (const bf16*)(ws + WS_WGU), T, 2 * FF, D}; pg8::StaticOrder S; S.init(T, 2 * FF, F.G, F.bid);
      pg8::EpiSwiglu E{proj + C_ACT, PJ, ssq2};
      pg8::gemm_phase<pg8::EpiSwiglu, pg8::StaticOrder, true, true>(F.lds + RING_OFF, g, S, E); }
    GRID_BAR();
    { pg8::Gemm g{proj + C_ACT, PJ, (const bf16*)(ws + WS_WD), T, D, FF}; pg8::StaticOrder S; S.init(T, D, F.G, F.bid);
      pg8::EpiRes E{args.out, args.out, proj + C_X2B, PJ, ssq3};
      pg8::gemm_phase<pg8::EpiRes, pg8::StaticOrder, true, true>(F.lds + RING_OFF, g, S, E); }
    GRID_BAR();
    s_final(F, args, ssq3);
}

extern "C" void kernel_launch(void* const* d_in, const int* in_sizes, int n_in, void* d_out, int out_size, void* d_ws, size_t ws_size, hipStream_t stream) {
    static int grid = 0;
    if (grid == 0) {
        if (n_in != 23 || in_sizes[0] != T * D || out_size != T * D || ws_size < WS_END) { fprintf(stderr, "kernel_launch: unexpected shapes / workspace (n_in %d, ws %zu, need %zu)\n", n_in, ws_size, (size_t)WS_END); grid = -1; return; }
        int dev = 0, cus = 0, per_cu = 0;
        if (hipGetDevice(&dev) != hipSuccess || hipDeviceGetAttribute(&cus, hipDeviceAttributeMultiprocessorCount, dev) != hipSuccess) { grid = -1; return; }
        if (hipFuncSetAttribute((const void*)hybrid_fwd, hipFuncAttributeMaxDynamicSharedMemorySize, LDS_BYTES) != hipSuccess) { fprintf(stderr, "kernel_launch: hipFuncSetAttribute failed\n"); grid = -1; return; }
        if (hipOccupancyMaxActiveBlocksPerMultiprocessor(&per_cu, (const void*)hybrid_fwd, NWAVES * 64, LDS_BYTES) != hipSuccess || per_cu < 1) { fprintf(stderr, "kernel_launch: occupancy query says %d blocks per CU\n", per_cu); }
        (void)hipGetLastError();
        grid = cus;
    }
    if (grid < 0) return;
    if (hipMemsetAsync((char*)d_ws + WS_CTL, 0, CTL_ZERO_BYTES, stream) != hipSuccess) return;
    Args a{};
    for (int i = 0; i < 23; ++i) a.in[i] = (const float*)d_in[i];
    a.out = (float*)d_out; a.ws = (unsigned char*)d_ws;
    hipLaunchKernelGGL(hybrid_fwd, dim3(grid), dim3(NWAVES * 64), LDS_BYTES, stream, a);
}
```

```cpp
#include <hip/hip_runtime.h>
#include <cstdio>
#include <cstdint>

#define GAS __attribute__((address_space(1)))
#define LAS __attribute__((address_space(3)))
typedef unsigned short bf16;
typedef unsigned v4u __attribute__((ext_vector_type(4)));
typedef unsigned v2u __attribute__((ext_vector_type(2)));
typedef float f32x4 __attribute__((ext_vector_type(4)));
typedef float f32x2 __attribute__((ext_vector_type(2)));
typedef short bf16x8 __attribute__((ext_vector_type(8)));
typedef GAS unsigned gu32;

constexpr int BATCH = 2, SEQ = 16384, D = 1024, T = BATCH * SEQ;
constexpr int MEMLEN = 256, NIN = 6672, FF = 2816;
constexpr float EPS = 1e-6f;
constexpr int PJ = 6656;
constexpr int C_Z = 0, C_G = 1024, C_X = 2048, C_B = 3072, C_C = 3328, C_Q = 3584, C_F = 4608, C_I = 5632;
constexpr int C_X1B = 2048, C_QA = 3072, C_OX = 4096, C_X2B = 5120, C_ACT = 0;

constexpr size_t MiB = 1u << 20;
constexpr size_t WS_CTL = 0, CTL_ZERO_BYTES = 1 * MiB;
constexpr int CW_BAR = 4096;
constexpr int CW_SSQ1 = 32768, CW_SSQ2 = CW_SSQ1 + T, CW_SSQ3 = CW_SSQ2 + T;
constexpr int CW_SSQY = CW_SSQ3 + T;
static_assert((size_t)(CW_SSQY + 2 * T) * 4 <= CTL_ZERO_BYTES, "ctl");
constexpr size_t WS_DT = 1 * MiB;
constexpr size_t WS_KM = 3 * MiB;
constexpr size_t WS_VT = 4 * MiB;
constexpr size_t WS_HDEC = 5 * MiB;
constexpr size_t WS_CDEC = 7 * MiB;
constexpr size_t WS_RSTD0 = 7 * MiB + 65536;
constexpr size_t WS_WOUT = 7 * MiB + 512 * 1024;
constexpr size_t WS_WQ = WS_WOUT + 4 * MiB;
constexpr size_t WS_WO = WS_WQ + 2 * MiB;
constexpr size_t WS_WGU = WS_WO + 2 * MiB;
constexpr size_t WS_WD = WS_WGU + 11 * MiB;
constexpr size_t WS_PROJ = 32 * MiB;
constexpr size_t WS_R = 448 * MiB;
constexpr size_t WS_WIN = WS_R;
constexpr size_t WS_SST = WS_R;
constexpr size_t WS_END = 512 * MiB;
static_assert(WS_WD + (size_t)1024 * FF * 2 <= WS_PROJ && WS_PROJ + (size_t)T * PJ * 2 <= WS_R, "ws");
static_assert(WS_END <= 512 * MiB, "ws");

constexpr int NWAVES = 8;
constexpr int RING_OFF = 0, RING_BYTES = 131072;
constexpr int LDS_BYTES = 147456;
constexpr int LDSCTL_OFF = LDS_BYTES - 1024, MISC_OFF = LDSCTL_OFF;

#define RLX_AGENT __ATOMIC_RELAXED, __HIP_MEMORY_SCOPE_AGENT
#define LDS_WAIT() asm volatile("s_waitcnt lgkmcnt(0)" ::: "memory")
#define VM_WAIT() asm volatile("s_waitcnt vmcnt(0)" ::: "memory")
__device__ __forceinline__ unsigned f2bf(float f) { unsigned u = __builtin_bit_cast(unsigned, f); return (u + 0x7fffu + ((u >> 16) & 1u)) >> 16; }
__device__ __forceinline__ unsigned pk2(float lo, float hi) { return f2bf(lo) | (f2bf(hi) << 16); }
__device__ __forceinline__ float bf2f(unsigned b) { return __builtin_bit_cast(float, b << 16); }
__device__ __forceinline__ float bflo(unsigned w) { return __builtin_bit_cast(float, w << 16); }
__device__ __forceinline__ float bfhi(unsigned w) { return __builtin_bit_cast(float, w & 0xffff0000u); }
__device__ __forceinline__ float sigmoidf_(float x) { return 1.f / (1.f + __expf(-x)); }
__device__ __forceinline__ float siluf_(float x) { return x / (1.f + __expf(-x)); }
__device__ __forceinline__ float softplusf_(float x) { return x > 20.f ? x : log1pf(__expf(x)); }
__device__ __forceinline__ float wave_sum(float v) {
#pragma unroll
    for (int o = 1; o < 64; o <<= 1) v += __shfl_xor(v, o);
    return v;
}
__device__ __forceinline__ float wave_max(float v) {
#pragma unroll
    for (int o = 1; o < 64; o <<= 1) v = fmaxf(v, __shfl_xor(v, o));
    return v;
}

#define XB_TMO      128
#define XB_XCNT(j)  (256  + 64 * (j))
#define XB_XSUB(j)  (1280 + 64 * (j))
#define XB_XGEN(j)  (2304 + 64 * (j))
#define XB_TOP      3328
#define XB_TOPGEN   3392
#define XCD_BAR_WORDS 3456
#define XB_SPIN_CAP (1u << 22)
__device__ __forceinline__ unsigned xb_ld(unsigned* p)              { return __hip_atomic_load(p, __ATOMIC_RELAXED, __HIP_MEMORY_SCOPE_AGENT); }
__device__ __forceinline__ unsigned xb_add(unsigned* p, unsigned v) { return __hip_atomic_fetch_add(p, v, __ATOMIC_RELAXED, __HIP_MEMORY_SCOPE_AGENT); }
__device__ __forceinline__ unsigned xb_xcc_id() { return (unsigned)__builtin_amdgcn_s_getreg((3 << 11) | 20) & 0xFu; }
#define XB_SPIN(cond, bar) do { unsigned _sp = 0; while (cond) { __builtin_amdgcn_s_sleep(1); \
    if ((++_sp & 255u) == 0u) { if (xb_ld(&(bar)[XB_TMO])) break; if (_sp > XB_SPIN_CAP) { atomicAdd(&(bar)[XB_TMO], 1u); break; } } } } while (0)
struct XcdBarrier { unsigned* bar; unsigned x; volatile LAS unsigned* st; };
__device__ __forceinline__ XcdBarrier xcd_barrier_post(unsigned* bar, volatile LAS unsigned* st) {
    XcdBarrier b; b.bar = bar; b.x = xb_xcc_id(); b.st = st;
    if (threadIdx.x == 0) (void)xb_add(&bar[XB_XCNT(b.x)], 1u);
    return b;
}
__device__ __forceinline__ void xcd_barrier_complete(unsigned* bar, unsigned x, unsigned& nloc, unsigned& nx) {
    const unsigned G = gridDim.x * gridDim.y * gridDim.z;
    unsigned sum, cnt, mine, sp = 0u;
    for (;;) {
        sum = 0u; cnt = 0u; mine = 0u;
#pragma unroll
        for (unsigned j = 0; j < 16; ++j) { const unsigned c = xb_ld(&bar[XB_XCNT(j)]); sum += c; cnt += (c > 0u) ? 1u : 0u; mine = (j == x) ? c : mine; }
        if (sum == G) break;
        __builtin_amdgcn_s_sleep(1);
        if ((++sp & 255u) == 0u) { if (xb_ld(&bar[XB_TMO])) break; if (sp > XB_SPIN_CAP) { atomicAdd(&bar[XB_TMO], 1u); break; } }
    }
    nloc = mine > 0u ? mine : 1u; nx = cnt > 0u ? cnt : 1u;
}
__device__ __forceinline__ void xcd_barrier(const XcdBarrier& b) {
    asm volatile("s_waitcnt vmcnt(0)" ::: "memory");
    __syncthreads();
    if (threadIdx.x == 0) {
        unsigned* bar = b.bar;
        __builtin_amdgcn_s_waitcnt(0);
        unsigned nloc = b.st[0], nx = b.st[1];
        if (nloc == 0u) { xcd_barrier_complete(bar, b.x, nloc, nx); b.st[0] = nloc; b.st[1] = nx; }
        const unsigned old = xb_add(&bar[XB_XSUB(b.x)], 1u);
        const unsigned gen = old / nloc;
        if (old + 1u == (gen + 1u) * nloc) {
            __builtin_amdgcn_fence(__ATOMIC_RELEASE, "agent");
            asm volatile("s_waitcnt vmcnt(0)" ::: "memory");
            const unsigned og = xb_add(&bar[XB_TOP], 1u);
            const unsigned tg = og / nx;
            if (og + 1u == (tg + 1u) * nx) xb_add(&bar[XB_TOPGEN], 1u);
            else XB_SPIN(xb_ld(&bar[XB_TOPGEN]) == tg, bar);
            __builtin_amdgcn_fence(__ATOMIC_ACQUIRE, "agent");
            xb_add(&bar[XB_XGEN(b.x)], 1u);
            asm volatile("s_waitcnt vmcnt(0)" ::: "memory");
        } else {
            XB_SPIN(xb_ld(&bar[XB_XGEN(b.x)]) == gen, bar);
            __builtin_amdgcn_fence(__ATOMIC_ACQUIRE, "agent");
            asm volatile("s_waitcnt vmcnt(0)" ::: "memory");
        }
    }
    __syncthreads();
}

namespace pg8 {
#define PG8_LAS __attribute__((address_space(3)))
typedef unsigned short bf16_t;
typedef unsigned u32x4 __attribute__((ext_vector_type(4)));
constexpr int BM = 256, BK = 64, HALF = 128, HTB = HALF * BK * 2, STAGE_BYTES = 8 * HTB, NXCD = 8, WGM = 8;
__host__ __device__ __forceinline__ int lds_byte(int r, int c) { const int st = (r >> 4) * 2 + (c >> 5), rr = r & 15, cc = c & 31, ob = rr * 64 + cc * 2; return st * 1024 + (ob ^ (((ob >> 9) & 1) << 5)); }
__host__ __device__ __forceinline__ void stage_rc(int b, int& R, int& C) { const int st = b / 1024, sb = b % 1024, swz = sb ^ (((sb >> 9) & 1) << 5); R = (st >> 1) * 16 + swz / 64; C = (st & 1) * 32 + (swz % 64) / 2; }
__host__ __device__ __forceinline__ int perm32(int rho) { const int n = rho >> 4, i = rho & 15; return 8 * (i >> 2) + 4 * n + (i & 3); }
struct Unit { int pm, pn; };
struct Gemm { const bf16_t* A; int lda; const bf16_t* Bt; int M, N, K; };
struct StaticOrder {
    int nM, nN, nwg, G, c;
    __host__ __device__ void init(int M, int N, int G_, int c_) { nM = M / BM; nN = N / BM; nwg = nM * nN; G = G_; c = c_; }
    __host__ __device__ bool next(int i, Unit& u) const {
        const long L = (long)i * G + c; if (L >= nwg) return false;
        int wgid = (int)L; { const int q = nwg / NXCD, r = nwg % NXCD, xcd = wgid % NXCD, off = wgid / NXCD; wgid = (xcd < r ? xcd * (q + 1) : r * (q + 1) + (xcd - r) * q) + off; }
        const int nig = WGM * nN, gid = wgid / nig, fm = gid * WGM, gsz = (nM - fm) < WGM ? (nM - fm) : WGM;
        u.pm = fm + ((wgid % nig) % gsz); u.pn = (wgid % nig) / gsz; return true;
    }
    __device__ __forceinline__ void a_ready(const Unit&) const {}
    __device__ __forceinline__ void done(const Unit&) const {}
};
__device__ __forceinline__ unsigned cvt_pk_bf16(float lo, float hi) { unsigned r; asm volatile("v_cvt_pk_bf16_f32 %0, %1, %2" : "=v"(r) : "v"(lo), "v"(hi)); return r; }

template <int MODE> struct EpiScaleBf16 {
    static constexpr bool PERM = true, AFTER_DRAIN = false;
    bf16_t* O; int ldc; const float* rs;
    __device__ __forceinline__ void operator()(const f32x4 (&acc)[2][2][4][2], const Unit& u, int wr, int wc, int fr, int fq) const {
        const int row0 = u.pm * BM + wr * 64 + fr; const int col0 = u.pn * BM + wc * 32 + 8 * fq;
#pragma unroll
        for (int ai = 0; ai < 2; ++ai)
#pragma unroll
            for (int m = 0; m < 4; ++m) { const int row = row0 + ai * HALF + m * 16; float sc = rs[row]; if (MODE == 1) sc = 1.0f / sqrtf(sc * (1.0f / 1024.0f) + 1e-6f);
                bf16_t* rowp = O + (size_t)row * ldc + col0;
#pragma unroll
                for (int bj = 0; bj < 2; ++bj) { const f32x4 v0 = acc[ai][bj][m][0] * sc, v1 = acc[ai][bj][m][1] * sc; u32x4 w;
                    w.x = cvt_pk_bf16(v0[0], v0[1]); w.y = cvt_pk_bf16(v0[2], v0[3]); w.z = cvt_pk_bf16(v1[0], v1[1]); w.w = cvt_pk_bf16(v1[2], v1[3]);
                    *(u32x4*)(rowp + bj * HALF) = w; } }
    }
};
struct EpiSwiglu {
    static constexpr bool PERM = true, AFTER_DRAIN = false;
    bf16_t* O; int ldc; const float* ssq;
    __device__ __forceinline__ void operator()(const f32x4 (&acc)[2][2][4][2], const Unit& u, int wr, int wc, int fr, int fq) const {
        const int row0 = u.pm * BM + wr * 64 + fr; const int col0 = u.pn * HALF + wc * 32 + 8 * fq;
#pragma unroll
        for (int ai = 0; ai < 2; ++ai)
#pragma unroll
            for (int m = 0; m < 4; ++m) { const int row = row0 + ai * HALF + m * 16; const float sc = 1.0f / sqrtf(ssq[row] * (1.0f / 1024.0f) + 1e-6f);
                float o[8];
#pragma unroll
                for (int n = 0; n < 2; ++n)
#pragma unroll
                    for (int i = 0; i < 4; ++i) { const float g = acc[ai][0][m][n][i] * sc, up = acc[ai][1][m][n][i] * sc; o[n * 4 + i] = g / (1.0f + __expf(-g)) * up; }
                u32x4 w; w.x = cvt_pk_bf16(o[0], o[1]); w.y = cvt_pk_bf16(o[2], o[3]); w.z = cvt_pk_bf16(o[4], o[5]); w.w = cvt_pk_bf16(o[6], o[7]);
                *(u32x4*)(O + (size_t)row * ldc + col0) = w; }
    }
};
struct EpiRes {
    static constexpr bool PERM = false, AFTER_DRAIN = false;
    const float* xold; float* xnew; bf16_t* XB; int ldb; float* ssq;
    __device__ __forceinline__ void operator()(const f32x4 (&acc)[2][2][4][2], const Unit& u, int wr, int wc, int fr, int fq) const {
        const int row0 = u.pm * BM + wr * 64 + fr; const int col0 = u.pn * BM + wc * 32 + 4 * fq;
#pragma unroll
        for (int ai = 0; ai < 2; ++ai)
#pragma unroll
            for (int m = 0; m < 4; ++m) { const int row = row0 + ai * HALF + m * 16; const size_t off = (size_t)row * 1024 + col0; float s = 0.f;
#pragma unroll
                for (int bj = 0; bj < 2; ++bj)
#pragma unroll
                    for (int n = 0; n < 2; ++n) { const f32x4 xo = *(const f32x4*)(xold + off + bj * HALF + n * 16); const f32x4 xn = xo + acc[ai][bj][m][n];
                        *(f32x4*)(xnew + off + bj * HALF + n * 16) = xn; s += (xn[0] * xn[0] + xn[1] * xn[1]) + (xn[2] * xn[2] + xn[3] * xn[3]);
                        v2u w; w.x = cvt_pk_bf16(xn[0], xn[1]); w.y = cvt_pk_bf16(xn[2], xn[3]);
                        *(v2u*)(XB + (size_t)row * ldb + col0 + bj * HALF + n * 16) = w; }
                s += __shfl_xor(s, 16); s += __shfl_xor(s, 32);
                if (fq == 0) atomicAdd(ssq + row, s);
                if (m & 1) asm volatile("" ::: "memory"); }
    }
};

template <class Epi, class Sched, bool ALIGN_EPI = false, bool SP2 = false>
__device__ __forceinline__ void gemm_phase(PG8_LAS unsigned char* lds, const Gemm g, const Sched& S, const Epi& E) {
    const int tid = threadIdx.x, wid = __builtin_amdgcn_readfirstlane(tid >> 6), lane = tid & 63, wr = wid >> 2, wc = wid & 3, fr = lane & 15, fq = lane >> 4;
    const int K = g.K, nt = K / BK, lda = g.lda;
    unsigned voffA[2], voffB[2];
#pragma unroll
    for (int i = 0; i < 2; ++i) { int R, C; stage_rc(tid * 16 + i * 8192, R, C); const int Rb = Epi::PERM ? ((R & ~31) + perm32(R & 31)) : R;
        voffA[i] = (unsigned)(R * lda + C) * 2u; voffB[i] = (unsigned)(Rb * K + C) * 2u; }
    const size_t kstep = (size_t)(BK * 2);
    const size_t hstepA = (size_t)HALF * lda * 2, hstepB = (size_t)HALF * K * 2;
    const size_t tstepA = 2 * hstepA, tstepB = 2 * hstepB;
    const unsigned ldsw = (unsigned)wid * 1024u;
    const int aoff = lds_byte(wr * 64 + fr, fq * 8), boff = lds_byte(wc * 32 + fr, fq * 8);
#define PG8_SA(b, h) (((b) * 2 + (h)) * HTB)
#define PG8_SB(b, h) ((4 + (b) * 2 + (h)) * HTB)
#define PG8_STAGE(bufoff, gbase, voff) do { _Pragma("unroll") for (int _i = 0; _i < 2; ++_i) \
        __builtin_amdgcn_global_load_lds((const unsigned*)((const char*)(gbase) + (voff)[_i]), (PG8_LAS unsigned*)(lds + (bufoff) + ldsw + _i * 8192), 16, 0, 0); } while (0)
#define PG8_LDA(dst, b, h) do { _Pragma("unroll") for (int m = 0; m < 4; ++m) _Pragma("unroll") for (int k = 0; k < 2; ++k) dst[m][k] = *(const PG8_LAS bf16x8*)(lds + PG8_SA(b, h) + aoff + m * 2048 + k * 1024); } while (0)
#define PG8_LDB(dst, b, h) do { _Pragma("unroll") for (int n = 0; n < 2; ++n) _Pragma("unroll") for (int k = 0; k < 2; ++k) dst[n][k] = *(const PG8_LAS bf16x8*)(lds + PG8_SB(b, h) + boff + n * 2048 + k * 1024); } while (0)
#define PG8_MMA(ai, bj, At, Bt) do { __builtin_amdgcn_s_setprio(1); _Pragma("unroll") for (int m = 0; m < 4; ++m) _Pragma("unroll") for (int n = 0; n < 2; ++n) _Pragma("unroll") for (int k = 0; k < 2; ++k) \
        acc[ai][bj][m][n] = __builtin_amdgcn_mfma_f32_16x16x32_bf16(Bt[n][k], At[m][k], acc[ai][bj][m][n], 0, 0, 0); __builtin_amdgcn_s_setprio(0); } while (0)
#define PG8_WAIT_V(n) asm volatile("s_waitcnt vmcnt(" #n ")" ::: "memory")
#define PG8_WAIT_L(n) asm volatile("s_waitcnt lgkmcnt(" #n ")" ::: "memory")
#define PG8_BAR __builtin_amdgcn_s_barrier()
#define PG8_SCHED __builtin_amdgcn_sched_barrier(0)
    Unit cur, nxt; int ui = 0;
    if (!S.next(0, cur)) return;
    f32x4 acc[2][2][4][2];
#pragma unroll
    for (int a = 0; a < 2; ++a)
#pragma unroll
        for (int b = 0; b < 2; ++b)
#pragma unroll
            for (int m = 0; m < 4; ++m)
#pragma unroll
                for (int n = 0; n < 2; ++n) acc[a][b][m][n] = (f32x4){0.f, 0.f, 0.f, 0.f};
    bf16x8 At[4][2], B0[2][2], B1[2][2];
    const char* cA = (const char*)g.A + (size_t)cur.pm * tstepA; const char* cB = (const char*)g.Bt + (size_t)cur.pn * tstepB;
    S.a_ready(cur);
    if constexpr (SP2) {
        PG8_STAGE(PG8_SB(0, 0), cB, voffB); PG8_STAGE(PG8_SB(0, 1), cB + hstepB, voffB); PG8_STAGE(PG8_SA(0, 0), cA, voffA); PG8_STAGE(PG8_SA(0, 1), cA + hstepA, voffA);
        if (wr == 1) PG8_BAR;
        PG8_WAIT_V(2); PG8_BAR;
        PG8_STAGE(PG8_SB(1, 0), cB + kstep, voffB); PG8_STAGE(PG8_SA(1, 0), cA + kstep, voffA); PG8_STAGE(PG8_SB(1, 1), cB + hstepB + kstep, voffB);
        PG8_WAIT_V(6); PG8_BAR;
    } else {
        PG8_STAGE(PG8_SB(0, 0), cB, voffB); PG8_STAGE(PG8_SA(0, 0), cA, voffA); PG8_STAGE(PG8_SB(0, 1), cB + hstepB, voffB); PG8_STAGE(PG8_SA(0, 1), cA + hstepA, voffA);
        if (wr == 1) PG8_BAR;
        PG8_WAIT_V(4); PG8_BAR;
        PG8_STAGE(PG8_SB(1, 0), cB + kstep, voffB); PG8_STAGE(PG8_SA(1, 0), cA + kstep, voffA); PG8_STAGE(PG8_SB(1, 1), cB + hstepB + kstep, voffB);
        PG8_WAIT_V(6); PG8_BAR;
    }
    for (;;) {
        const bool has_next = S.next(ui + 1, nxt);
        const char* nA = has_next ? (const char*)g.A + (size_t)nxt.pm * tstepA : cA; const char* nB = has_next ? (const char*)g.Bt + (size_t)nxt.pn * tstepB : cB;
        for (int t = 0; t < nt; t += 2) {
            const bool last = (t == nt - 2);
            const char* a1 = cA + (size_t)(t + 1) * kstep;
            const char* a2 = last ? nA : cA + (size_t)(t + 2) * kstep; const char* b2 = last ? nB : cB + (size_t)(t + 2) * kstep;
            const char* a3 = a2 + kstep; const char* b3 = b2 + kstep;
            if (last && has_next) S.a_ready(nxt);
            if constexpr (SP2) {
            PG8_LDB(B0, 0, 0); PG8_LDB(B1, 0, 1); PG8_SCHED; PG8_LDA(At, 0, 0); PG8_STAGE(PG8_SA(1, 1), a1 + hstepA, voffA);
            PG8_WAIT_V(8); PG8_WAIT_L(0); PG8_BAR; PG8_MMA(0, 0, At, B0); PG8_MMA(0, 1, At, B1); PG8_BAR; PG8_SCHED;
            PG8_LDA(At, 0, 1); PG8_STAGE(PG8_SB(0, 0), b2, voffB); PG8_STAGE(PG8_SB(0, 1), b2 + hstepB, voffB); PG8_STAGE(PG8_SA(0, 0), a2, voffA);
            PG8_WAIT_V(8); PG8_WAIT_L(0); PG8_BAR; PG8_MMA(1, 0, At, B0); PG8_MMA(1, 1, At, B1); PG8_BAR; PG8_SCHED;
            PG8_LDB(B0, 1, 0); PG8_LDB(B1, 1, 1); PG8_SCHED; PG8_LDA(At, 1, 0); PG8_STAGE(PG8_SA(0, 1), a2 + hstepA, voffA);
            PG8_WAIT_V(8); PG8_WAIT_L(0); PG8_BAR; PG8_MMA(0, 0, At, B0); PG8_MMA(0, 1, At, B1); PG8_BAR; PG8_SCHED;
            PG8_LDA(At, 1, 1); PG8_STAGE(PG8_SB(1, 0), b3, voffB); PG8_STAGE(PG8_SB(1, 1), b3 + hstepB, voffB); PG8_STAGE(PG8_SA(1, 0), a3, voffA);
            PG8_WAIT_V(8); PG8_WAIT_L(0); PG8_BAR; PG8_MMA(1, 0, At, B0); PG8_MMA(1, 1, At, B1); PG8_BAR; PG8_SCHED;
            } else {
            PG8_LDB(B0, 0, 0); PG8_SCHED; PG8_LDA(At, 0, 0); PG8_STAGE(PG8_SA(1, 1), a1 + hstepA, voffA);
            PG8_WAIT_L(8); PG8_BAR; PG8_WAIT_L(0); PG8_MMA(0, 0, At, B0); PG8_BAR; PG8_SCHED;
            PG8_LDB(B1, 0, 1); PG8_STAGE(PG8_SB(0, 0), b2, voffB);
            PG8_BAR; PG8_WAIT_L(0); PG8_MMA(0, 1, At, B1); PG8_BAR;
            PG8_LDA(At, 0, 1); PG8_STAGE(PG8_SA(0, 0), a2, voffA);
            PG8_BAR; PG8_WAIT_L(0); PG8_MMA(1, 0, At, B0); PG8_BAR; PG8_SCHED;
            PG8_STAGE(PG8_SB(0, 1), b2 + hstepB, voffB);
            PG8_WAIT_V(6); PG8_BAR; PG8_MMA(1, 1, At, B1); PG8_BAR;
            PG8_LDB(B0, 1, 0); PG8_SCHED; PG8_LDA(At, 1, 0); PG8_STAGE(PG8_SA(0, 1), a2 + hstepA, voffA);
            PG8_WAIT_L(8); PG8_BAR; PG8_WAIT_L(0); PG8_MMA(0, 0, At, B0); PG8_BAR; PG8_SCHED;
            PG8_LDB(B1, 1, 1); PG8_STAGE(PG8_SB(1, 0), b3, voffB);
            PG8_BAR; PG8_WAIT_L(0); PG8_MMA(0, 1, At, B1); PG8_BAR;
            PG8_LDA(At, 1, 1); PG8_STAGE(PG8_SA(1, 0), a3, voffA);
            PG8_BAR; PG8_WAIT_L(0); PG8_MMA(1, 0, At, B0); PG8_BAR; PG8_SCHED;
            PG8_STAGE(PG8_SB(1, 1), b3 + hstepB, voffB);
            PG8_WAIT_V(6); PG8_BAR; PG8_MMA(1, 1, At, B1); PG8_BAR;
            }
        }
        if constexpr (ALIGN_EPI) { if (wr == 0) PG8_BAR; }
        if constexpr (!Epi::AFTER_DRAIN) { E(acc, cur, wr, wc, fr, fq); S.done(cur); }
        if (!has_next) break;
#pragma unroll
        for (int a = 0; a < 2; ++a)
#pragma unroll
            for (int b = 0; b < 2; ++b)
#pragma unroll
                for (int m = 0; m < 4; ++m)
#pragma unroll
                    for (int n = 0; n < 2; ++n) acc[a][b][m][n] = (f32x4){0.f, 0.f, 0.f, 0.f};
        cur = nxt; cA = nA; cB = nB; ++ui;
        if constexpr (ALIGN_EPI) { if (wr == 1) PG8_BAR; }
    }
    PG8_WAIT_V(0);
    if constexpr (!ALIGN_EPI) { if (wr == 0) PG8_BAR; }
    PG8_BAR;
#undef PG8_SA
#undef PG8_SB
#undef PG8_STAGE
#undef PG8_LDA
#undef PG8_LDB
#undef PG8_MMA
#undef PG8_WAIT_V
#undef PG8_WAIT_L
#undef PG8_BAR
#undef PG8_SCHED
}
}

struct Args { const float* in[23]; float* out; unsigned char* ws; };
struct Frame {
    LAS unsigned char* lds;
    int tid, lane, wave, G, bid;
};

__device__ __forceinline__ void p0_transpose_item(const float* W, int ldw, int col0, int K, bf16* WT, int dst_row0, int k0, const float* ks, float mul, LAS float* scr, int lane) {
#pragma unroll 8
    for (int i = 0; i < 32; ++i) { const int kk = 2 * i + (lane >> 5); float v = W[(size_t)(k0 + kk) * ldw + col0 + (lane & 31)]; if (ks) v *= ks[kk]; scr[kk * 33 + (lane & 31)] = v * mul; }
    LDS_WAIT(); asm volatile("" ::: "memory");
    const int c = lane & 7;
#pragma unroll
    for (int j = 0; j < 4; ++j) { const int n = (lane >> 3) + 8 * j; const LAS float* s = scr + (8 * c) * 33 + n;
        v4u o; o.x = pk2(s[0 * 33], s[1 * 33]); o.y = pk2(s[2 * 33], s[3 * 33]); o.z = pk2(s[4 * 33], s[5 * 33]); o.w = pk2(s[6 * 33], s[7 * 33]);
        *(v4u*)(WT + (size_t)(dst_row0 + n) * K + k0 + 8 * c) = o; }
    LDS_WAIT(); asm volatile("" ::: "memory");
}

__device__ __forceinline__ void p0_prologue(const Frame& F, const Args& a) {
    unsigned char* ws = a.ws;
    const int gw = F.bid * NWAVES + F.wave, NGW = F.G * NWAVES;
    {
        LAS float* scr = (LAS float*)(F.lds + F.wave * 8704);
        bf16* WinT = (bf16*)(ws + WS_WIN); bf16* WoutT = (bf16*)(ws + WS_WOUT); bf16* WqT = (bf16*)(ws + WS_WQ); bf16* WoT = (bf16*)(ws + WS_WO); bf16* WguT = (bf16*)(ws + WS_WGU); bf16* WdT = (bf16*)(ws + WS_WD);
        constexpr int I_IN = 16 * (PJ / 32);
        constexpr int I_OUT = 32 * 32, I_Q = 16 * 32, I_O = 16 * 32, I_G = 16 * 88, I_U = 16 * 88, I_D = 44 * 32;
        constexpr int NITEMS = I_IN + I_OUT + I_Q + I_O + I_G + I_U + I_D;
        for (int it = gw; it < NITEMS; it += NGW) {
            int r = it;
            if (r < I_IN) { const int nblk = PJ / 32, kb = r / nblk, nb = r % nblk, drow = nb * 32;
                int scol;
                if (drow < 1024) scol = drow;
                else if (drow < 2048) scol = 5648 + (drow - 1024);
                else if (drow < 3584) scol = 1024 + (drow - 2048);
                else if (drow < 4608) scol = 2576 + (drow - 3584);
                else if (drow < 5632) scol = 3600 + (drow - 4608);
                else scol = 4624 + (drow - 5632);
                p0_transpose_item(a.in[3], NIN, scol, 1024, WinT, drow, kb * 64, a.in[2] + kb * 64, 1.f, scr, F.lane); continue; }
            r -= I_IN;
            if (r < I_OUT) { const int kb = r / 32, nb = r % 32, k0 = kb * 64; const float* ks = (k0 < 1024) ? a.in[9] + k0 : a.in[11] + ((k0 - 1024) & 127);
                p0_transpose_item(a.in[12], 1024, nb * 32, 2048, WoutT, nb * 32, k0, ks, 1.f, scr, F.lane); continue; }
            r -= I_OUT;
            if (r < I_Q) { const int kb = r / 32, nb = r % 32; p0_transpose_item(a.in[15], 1024, nb * 32, 1024, WqT, nb * 32, kb * 64, a.in[13] + kb * 64, 0.0625f, scr, F.lane); continue; }
            r -= I_Q;
            if (r < I_O) { const int kb = r / 32, nb = r % 32; p0_transpose_item(a.in[17], 1024, nb * 32, 1024, WoT, nb * 32, kb * 64, nullptr, 1.f, scr, F.lane); continue; }
            r -= I_O;
            if (r < I_G) { const int kb = r / 88, nb = r % 88, c0 = nb * 32; p0_transpose_item(a.in[19], FF, c0, 1024, WguT, (c0 >> 7) * 256 + (c0 & 127), kb * 64, a.in[18] + kb * 64, 1.f, scr, F.lane); continue; }
            r -= I_G;
            if (r < I_U) { const int kb = r / 88, nb = r % 88, c0 = nb * 32; p0_transpose_item(a.in[20], FF, c0, 1024, WguT, (c0 >> 7) * 256 + 128 + (c0 & 127), kb * 64, a.in[18] + kb * 64, 1.f, scr, F.lane); continue; }
            r -= I_U;
            { const int kb = r / 32, nb = r % 32; p0_transpose_item(a.in[21], 1024, nb * 32, FF, WdT, nb * 32, kb * 64, nullptr, 1.f, scr, F.lane); }
        }
    }
    __syncthreads();
    LAS float* wdt = (LAS float*)(F.lds);
    for (int i = F.tid; i < 16 * 1024; i += NWAVES * 64) { const int k = i >> 4, c = i & 15; wdt[c * 1024 + k] = a.in[3][(size_t)k * NIN + 2560 + c] * a.in[2][k]; }
    __syncthreads();
    {
        bf16* XB = (bf16*)a.out; float* rstd0 = (float*)(ws + WS_RSTD0); float* dtb = (float*)(ws + WS_DT);
        for (int m = gw; m < T; m += NGW) {
            const f32x4* xr = (const f32x4*)(a.in[0] + (size_t)m * D) + F.lane;
            f32x4 v[4]; float s = 0.f;
#pragma unroll
            for (int j = 0; j < 4; ++j) { v[j] = xr[64 * j]; s += (v[j].x * v[j].x + v[j].y * v[j].y) + (v[j].z * v[j].z + v[j].w * v[j].w); }
            const float rstd = 1.0f / sqrtf(wave_sum(s) * (1.f / D) + EPS);
            unsigned long long* o8 = (unsigned long long*)(XB + (size_t)m * D) + F.lane;
#pragma unroll
            for (int j = 0; j < 4; ++j) o8[64 * j] = (unsigned long long)pk2(v[j].x, v[j].y) | ((unsigned long long)pk2(v[j].z, v[j].w) << 32);
            float mydt = 0.f;
#pragma unroll 1
            for (int c = 0; c < 16; ++c) { float d = 0.f;
#pragma unroll
                for (int j = 0; j < 4; ++j) { const f32x4 w = *(const LAS f32x4*)(wdt + c * 1024 + 256 * j + 4 * F.lane); d += (v[j].x * w.x + v[j].y * w.y) + (v[j].z * w.z + v[j].w * w.w); }
                d = wave_sum(d); if (F.lane == c) mydt = d; }
            if (F.lane == 0) rstd0[m] = rstd;
            if (F.lane < 16) dtb[(size_t)m * 16 + F.lane] = softplusf_(mydt * rstd + a.in[6][F.lane]);
        }
    }
    {
        bf16* KM = (bf16*)(ws + WS_KM); bf16* VT = (bf16*)(ws + WS_VT);
        for (int gt = F.bid * (NWAVES * 64) + F.tid; gt < 64 * 2048; gt += F.G * NWAVES * 64) {
            const int n = gt & 2047, mg = gt >> 11;
            const float* mem = a.in[1] + (size_t)mg * 8 * D; const float* wkv = a.in[16] + n; const float* nw = a.in[14];
            float acc[8], ss[8];
#pragma unroll
            for (int i = 0; i < 8; ++i) { acc[i] = 0.f; ss[i] = 0.f; }
            for (int k = 0; k < D; ++k) { const float w = wkv[(size_t)k * 2048] * nw[k];
#pragma unroll
                for (int i = 0; i < 8; ++i) { const float xv = mem[i * D + k]; acc[i] += xv * w; ss[i] += xv * xv; } }
#pragma unroll
            for (int i = 0; i < 8; ++i) { const int m = mg * 8 + i, b = m >> 8, key = m & 255; const float v = acc[i] / sqrtf(ss[i] * (1.f / D) + EPS);
                if (n < 1024) { const int h = n >> 8, d = n & 255; KM[(((size_t)b * 4 + h) * 256 + key) * 256 + d] = (bf16)f2bf(v); }
                else { const int h = (n - 1024) >> 8, d = n & 255; VT[(((size_t)b * 4 + h) * 256 + d) * 256 + key] = (bf16)f2bf(v); } }
        }
    }
}

__device__ __forceinline__ void s_conv(const Frame& F, const Args& a, const bf16* proj, bf16* XC) {
    const float* cw = a.in[4]; const float* cb = a.in[5];
    const size_t total = (size_t)T * 1536;
    for (size_t i = (size_t)F.bid * (NWAVES * 64) + F.tid; i < total; i += (size_t)F.G * NWAVES * 64) {
        const int row = (int)(i / 1536), ch = (int)(i % 1536), t = row & (SEQ - 1);
        float acc = cb[ch];
#pragma unroll
        for (int k = 0; k < 4; ++k) { const int tt = t - 3 + k; if (tt >= 0) acc += cw[k * 1536 + ch] * bf2f(proj[(size_t)(row - 3 + k) * PJ + C_X + ch]); }
        XC[i] = (bf16)f2bf(siluf_(acc));
    }
}
__device__ __forceinline__ void s_scan(const Frame& F, const Args& a, bf16* proj, const bf16* XC) {
    const float* dtb = (const float*)(a.ws + WS_DT);
    LAS float* sm = (LAS float*)F.lds;
    if (F.bid < 32) {
        const int b = F.bid >> 4, h = F.bid & 15, g = h >> 3, p = F.tid & 63, nq = F.tid >> 6;
        const float av = -__expf(a.in[7][h]), Dh = a.in[8][h];
        float st[16];
#pragma unroll
        for (int i = 0; i < 16; ++i) st[i] = 0.f;
        for (int t = 0; t < SEQ; ++t) {
            const size_t row = (size_t)b * SEQ + t;
            const float dt = dtb[row * 16 + h], dA = __expf(dt * av);
            const float xv = bf2f(XC[row * 1536 + h * 64 + p]);
            const bf16* Bp = XC + row * 1536 + 1024 + g * 128 + nq * 16; const bf16* Cp = Bp + 256;
            const float dx = dt * xv; float part = 0.f;
#pragma unroll
            for (int i = 0; i < 16; ++i) { st[i] = st[i] * dA + dx * bf2f(Bp[i]); part += st[i] * bf2f(Cp[i]); }
            LAS float* yb = sm + (t & 1) * 512;
            yb[nq * 64 + p] = part;
            __syncthreads();
            if (nq == 0) { float y = Dh * xv;
#pragma unroll
                for (int q = 0; q < 8; ++q) y += yb[q * 64 + p];
                bf16* zp = proj + row * PJ + C_Z + h * 64 + p; const float z = bf2f(*zp); *zp = (bf16)f2bf(y * siluf_(z)); }
        }
    }
}
__device__ __forceinline__ void s_scan_hg(const Frame& F, const Args& a, bf16* proj) {
    LAS float* sm = (LAS float*)F.lds;
    if (F.bid < 16) {
        const int bb = F.bid, b = bb >> 3, h = bb & 7, v = F.tid & 127, kq = F.tid >> 7;
        float lbv = 0.f; if (F.tid < 128) lbv = sigmoidf_(a.in[10][h * 128 + F.tid] - a.in[10][1024 + h * 128 + F.tid]);
        float S[32];
#pragma unroll
        for (int i = 0; i < 32; ++i) S[i] = 0.f;
        for (int t = 0; t < SEQ; ++t) {
            const size_t row = (size_t)b * SEQ + t;
            LAS float* fb = sm + 1024 + (t & 1) * 256; LAS float* qb = fb + 128; LAS float* pb = sm + 2048 + (t & 1) * 512;
            if (F.tid < 128) { const float hf = bf2f(proj[row * PJ + C_F + h * 128 + F.tid]), hq = bf2f(proj[row * PJ + C_Q + h * 128 + F.tid]);
                fb[F.tid] = lbv + (1.f - lbv) * sigmoidf_(hf); qb[F.tid] = siluf_(hq); }
            const float iv = bf2f(proj[row * PJ + C_I + h * 128 + v]);
            __syncthreads();
            float part = 0.f;
#pragma unroll
            for (int i = 0; i < 32; ++i) { const float f = fb[kq * 32 + i]; S[i] = f * S[i] + (1.f - f) * iv; part += S[i] * qb[kq * 32 + i]; }
            pb[kq * 128 + v] = part;
            __syncthreads();
            if (kq == 0) { const float o = (pb[v] + pb[128 + v]) + (pb[256 + v] + pb[384 + v]); proj[row * PJ + C_Q + h * 128 + v] = (bf16)f2bf(o); }
        }
    }
}
__device__ __forceinline__ void s_norms(const Frame& F, bf16* proj) {
    const int gw = F.bid * NWAVES + F.wave, NGW = F.G * NWAVES;
    for (int m = gw; m < T; m += NGW) {
        bf16* pr = proj + (size_t)m * PJ;
#pragma unroll
        for (int g = 0; g < 2; ++g) { v4u w = *(const v4u*)(pr + C_Z + g * 512 + 8 * F.lane); float x[8] = {bflo(w.x), bfhi(w.x), bflo(w.y), bfhi(w.y), bflo(w.z), bfhi(w.z), bflo(w.w), bfhi(w.w)};
            float s = 0.f;
#pragma unroll
            for (int i = 0; i < 8; ++i) s += x[i] * x[i];
            const float r = 1.0f / sqrtf(wave_sum(s) * (1.f / 512.f) + EPS);
            v4u o; o.x = pk2(x[0] * r, x[1] * r); o.y = pk2(x[2] * r, x[3] * r); o.z = pk2(x[4] * r, x[5] * r); o.w = pk2(x[6] * r, x[7] * r);
            *(v4u*)(pr + C_Z + g * 512 + 8 * F.lane) = o; }
#pragma unroll
        for (int h = 0; h < 8; ++h) { const unsigned w = *(const unsigned*)(pr + C_Q + h * 128 + 2 * F.lane); const unsigned gt = *(const unsigned*)(pr + C_G + h * 128 + 2 * F.lane);
            const float o0 = bflo(w), o1 = bfhi(w);
            const float r = 1.0f / sqrtf(wave_sum(o0 * o0 + o1 * o1) * (1.f / 128.f) + EPS);
            *(unsigned*)(pr + C_G + h * 128 + 2 * F.lane) = pk2(o0 * r * siluf_(bflo(gt)), o1 * r * siluf_(bfhi(gt))); }
    }
}
__device__ __forceinline__ void s_attn(const Frame& F, const Args& a, bf16* proj) {
    const bf16* KM = (const bf16*)(a.ws + WS_KM); const bf16* VT = (const bf16*)(a.ws + WS_VT);
    LAS float* qs = (LAS float*)F.lds + F.wave * 512; LAS float* ps = qs + 256;
    const int gw = F.bid * NWAVES + F.wave, NGW = F.G * NWAVES;
    for (int it = gw; it < T * 4; it += NGW) {
        const int row = it >> 2, h = it & 3, b = row >> 14;
        { const v2u w = *(const v2u*)(proj + (size_t)row * PJ + C_QA + h * 256 + 4 * F.lane); qs[4 * F.lane] = bflo(w.x); qs[4 * F.lane + 1] = bfhi(w.x); qs[4 * F.lane + 2] = bflo(w.y); qs[4 * F.lane + 3] = bfhi(w.y); }
        LDS_WAIT(); asm volatile("" ::: "memory");
        float s[4];
#pragma unroll
        for (int kk = 0; kk < 4; ++kk) { const bf16* kr = KM + (((size_t)b * 4 + h) * 256 + (F.lane + 64 * kk)) * 256; float acc = 0.f;
            for (int d = 0; d < 256; d += 8) { const v4u w = *(const v4u*)(kr + d);
                acc += qs[d] * bflo(w.x) + qs[d + 1] * bfhi(w.x) + qs[d + 2] * bflo(w.y) + qs[d + 3] * bfhi(w.y) + qs[d + 4] * bflo(w.z) + qs[d + 5] * bfhi(w.z) + qs[d + 6] * bflo(w.w) + qs[d + 7] * bfhi(w.w); }
            s[kk] = acc; }
        const float mx = wave_max(fmaxf(fmaxf(s[0], s[1]), fmaxf(s[2], s[3])));
        float sum = 0.f;
#pragma unroll
        for (int kk = 0; kk < 4; ++kk) { s[kk] = __expf(s[kk] - mx); sum += s[kk]; }
        const float inv = 1.0f / wave_sum(sum);
#pragma unroll
        for (int kk = 0; kk < 4; ++kk) ps[F.lane + 64 * kk] = s[kk] * inv;
        LDS_WAIT(); asm volatile("" ::: "memory");
#pragma unroll
        for (int j = 0; j < 4; ++j) { const int d = F.lane + 64 * j; const bf16* vr = VT + (((size_t)b * 4 + h) * 256 + d) * 256; float acc = 0.f;
            for (int k = 0; k < 256; k += 8) { const v4u w = *(const v4u*)(vr + k);
                acc += ps[k] * bflo(w.x) + ps[k + 1] * bfhi(w.x) + ps[k + 2] * bflo(w.y) + ps[k + 3] * bfhi(w.y) + ps[k + 4] * bflo(w.z) + ps[k + 5] * bfhi(w.z) + ps[k + 6] * bflo(w.w) + ps[k + 7] * bfhi(w.w); }
            proj[(size_t)row * PJ + C_OX + h * 256 + d] = (bf16)f2bf(acc); }
        LDS_WAIT(); asm volatile("" ::: "memory");
    }
}
__device__ __forceinline__ void s_final(const Frame& F, const Args& a, const float* ssq) {
    const int gw = F.bid * NWAVES + F.wave, NGW = F.G * NWAVES;
    for (int m = gw; m < T; m += NGW) {
        const float r = 1.0f / sqrtf(ssq[m] * (1.f / D) + EPS);
        f32x4* xr = (f32x4*)(a.out + (size_t)m * D) + F.lane; const f32x4* wr = (const f32x4*)a.in[22] + F.lane;
#pragma unroll
        for (int j = 0; j < 4; ++j) { f32x4 v = xr[64 * j]; const f32x4 w = wr[64 * j]; v = v * r * w; xr[64 * j] = v; }
    }
}


typedef float f32x16 __attribute__((ext_vector_type(16)));
typedef short s16x4 __attribute__((ext_vector_type(4)));
__device__ __forceinline__ unsigned cvtpk(float lo, float hi) { unsigned r; asm volatile("v_cvt_pk_bf16_f32 %0, %1, %2" : "=v"(r) : "v"(lo), "v"(hi)); return r; }
__device__ __forceinline__ unsigned offb(unsigned row, unsigned ch) { return 256u * row + 16u * (ch ^ (((row & 3u) << 2) | ((row >> 2) & 3u))); }
__device__ __forceinline__ bf16x8 frag_row(const LAS unsigned char* tile, int rb, int ks, int lane) { return *(const LAS bf16x8*)(tile + offb(rb * 32 + (lane & 31), 2 * ks + (lane >> 5))); }
template <bool PERM> __device__ __forceinline__ bf16x8 frag_tr(const LAS unsigned char* tile, int c, int ks, int lane) {
    const int h = lane >> 5, blk = (lane >> 4) & 1, q = (lane & 15) >> 2, p = lane & 3;
    const int r0 = 16 * ks + (PERM ? 4 * h : 8 * h) + q, r1 = r0 + (PERM ? 8 : 4);
    const unsigned chn = 4 * c + 2 * blk + (p >> 1);
    const s16x4 a = __builtin_amdgcn_ds_read_tr16_b64_v4i16((LAS s16x4*)(tile + offb(r0, chn) + 8 * (p & 1)));
    const s16x4 b = __builtin_amdgcn_ds_read_tr16_b64_v4i16((LAS s16x4*)(tile + offb(r1, chn) + 8 * (p & 1)));
    return (bf16x8){a[0], a[1], a[2], a[3], b[0], b[1], b[2], b[3]};
}
#define MFMA32(A, B, C) __builtin_amdgcn_mfma_f32_32x32x16_bf16(A, B, C, 0, 0, 0)
__device__ __forceinline__ void unpack8(const v4u w, float (&x)[8]) { x[0] = bflo(w.x); x[1] = bfhi(w.x); x[2] = bflo(w.y); x[3] = bfhi(w.y); x[4] = bflo(w.z); x[5] = bfhi(w.z); x[6] = bflo(w.w); x[7] = bfhi(w.w); }

template <int R, class Sink> __device__ __forceinline__ void conv_run(const bf16* src, int tseq0, int r0, const float* cw, const float* cb, int cch, Sink&& sink) {
    float w[4][8], bias[8];
#pragma unroll
    for (int k = 0; k < 4; ++k) { const f32x4 a0 = *(const f32x4*)(cw + k * 1536 + cch), a1 = *(const f32x4*)(cw + k * 1536 + cch + 4);
        w[k][0] = a0.x; w[k][1] = a0.y; w[k][2] = a0.z; w[k][3] = a0.w; w[k][4] = a1.x; w[k][5] = a1.y; w[k][6] = a1.z; w[k][7] = a1.w; }
    { const f32x4 a0 = *(const f32x4*)(cb + cch), a1 = *(const f32x4*)(cb + cch + 4); bias[0] = a0.x; bias[1] = a0.y; bias[2] = a0.z; bias[3] = a0.w; bias[4] = a1.x; bias[5] = a1.y; bias[6] = a1.z; bias[7] = a1.w; }
    float p3[8], p2[8], p1[8], cur[8];
    const v4u zero = {0u, 0u, 0u, 0u};
    { v4u t3 = zero, t2 = zero, t1 = zero;
      if (tseq0 + r0 - 3 >= 0) t3 = *(const v4u*)(src + (ptrdiff_t)(r0 - 3) * PJ);
      if (tseq0 + r0 - 2 >= 0) t2 = *(const v4u*)(src + (ptrdiff_t)(r0 - 2) * PJ);
      if (tseq0 + r0 - 1 >= 0) t1 = *(const v4u*)(src + (ptrdiff_t)(r0 - 1) * PJ);
      unpack8(t3, p3); unpack8(t2, p2); unpack8(t1, p1); }
#pragma unroll
    for (int i = 0; i < R; ++i) {
        const v4u t = *(const v4u*)(src + (ptrdiff_t)(r0 + i) * PJ); unpack8(t, cur);
        float o[8];
#pragma unroll
        for (int e = 0; e < 8; ++e) { const float acc = bias[e] + w[0][e] * p3[e] + w[1][e] * p2[e] + w[2][e] * p1[e] + w[3][e] * cur[e]; o[e] = siluf_(acc); p3[e] = p2[e]; p2[e] = p1[e]; p1[e] = cur[e]; }
        sink(r0 + i, o);
    }
}

__device__ __forceinline__ void ssd_passA(const Frame& F, const Args& a, const bf16* proj, bf16* Sst, float* cdec) {
    LAS unsigned char* TB = F.lds; LAS unsigned char* TX0 = F.lds + 32768;
    LAS float* WS = (LAS float*)(F.lds + 98304);
    const float* dtb = (const float*)(a.ws + WS_DT);
    const int lane = F.lane, wave = F.wave;
    for (int u = F.bid; u < 1024; u += F.G) {
        const int b = u >> 9, c = (u >> 2) & 127, hq = u & 3, g = hq >> 1;
        const size_t row0 = (size_t)b * SEQ + (size_t)c * 128;
        if (wave < 4) { const int hd = hq * 4 + wave; const float av = -__expf(a.in[7][hd]);
            const float dt0 = dtb[(row0 + 2 * lane) * 16 + hd], dt1 = dtb[(row0 + 2 * lane + 1) * 16 + hd];
            const float v0 = dt0 * av, v1 = dt1 * av; float incl = v0 + v1;
#pragma unroll
            for (int o = 1; o < 64; o <<= 1) { const float t = __shfl_up(incl, o); if (lane >= o) incl += t; }
            const float last = __shfl(incl, 63); const float ac1 = incl, ac0 = incl - v1;
            WS[wave * 128 + 2 * lane] = dt0 * __expf(last - ac0); WS[wave * 128 + 2 * lane + 1] = dt1 * __expf(last - ac1);
            if (lane == 63) cdec[((size_t)b * 128 + c) * 16 + hd] = __expf(last); }
        __syncthreads();
        { const int cx = F.tid & 31, rr = F.tid >> 5; LAS unsigned char* TX = TX0 + (cx >> 4) * 32768; const LAS float* wsr = WS + (cx >> 3) * 128;
          conv_run<8>(proj + row0 * PJ + C_X + hq * 256 + cx * 8, c * 128, rr * 8, a.in[4], a.in[5], hq * 256 + cx * 8,
              [&](int r, const float (&o)[8]) { const float sc = wsr[r]; v4u w; w.x = cvtpk(o[0] * sc, o[1] * sc); w.y = cvtpk(o[2] * sc, o[3] * sc); w.z = cvtpk(o[4] * sc, o[5] * sc); w.w = cvtpk(o[6] * sc, o[7] * sc);
                  *(LAS v4u*)(TX + offb(r, cx & 15)) = w; }); }
        { const int cb_ = F.tid & 15, rr = F.tid >> 4;
          conv_run<4>(proj + row0 * PJ + C_B + g * 128 + cb_ * 8, c * 128, rr * 4, a.in[4], a.in[5], 1024 + g * 128 + cb_ * 8,
              [&](int r, const float (&o)[8]) { v4u w; w.x = cvtpk(o[0], o[1]); w.y = cvtpk(o[2], o[3]); w.z = cvtpk(o[4], o[5]); w.w = cvtpk(o[6], o[7]); *(LAS v4u*)(TB + offb(r, cb_)) = w; }); }
        __syncthreads();
        { const int hh = wave >> 1, nh = wave & 1; const LAS unsigned char* TX = TX0 + (hh >> 1) * 32768; const int cbase = (hh & 1) * 2;
          f32x16 acc[2][2];
#pragma unroll
          for (int i = 0; i < 2; ++i)
#pragma unroll
              for (int j = 0; j < 2; ++j)
#pragma unroll
                  for (int r = 0; r < 16; ++r) acc[i][j][r] = 0.f;
#pragma unroll 2
          for (int ks = 0; ks < 8; ++ks) { bf16x8 A[2], B[2];
#pragma unroll
              for (int i = 0; i < 2; ++i) { A[i] = frag_tr<false>(TX, cbase + i, ks, lane); B[i] = frag_tr<false>(TB, 2 * nh + i, ks, lane); }
#pragma unroll
              for (int i = 0; i < 2; ++i)
#pragma unroll
                  for (int j = 0; j < 2; ++j) acc[i][j] = MFMA32(A[i], B[j], acc[i][j]); }
          bf16* sp = Sst + (((size_t)b * 128 + c) * 16 + hq * 4 + hh) * 8192;
#pragma unroll
          for (int i = 0; i < 2; ++i)
#pragma unroll
              for (int j = 0; j < 2; ++j)
#pragma unroll
                  for (int r = 0; r < 16; ++r) { const int p = 32 * i + (r & 3) + 8 * (r >> 2) + 4 * (lane >> 5), n = 64 * nh + 32 * j + (lane & 31); sp[p * 128 + n] = (bf16)f2bf(acc[i][j][r]); } }
        __syncthreads();
    }
}
__device__ __forceinline__ void ssd_scan(const Frame& F, bf16* Sst, const float* cdec) {
    for (int gid = F.bid * (NWAVES * 64) + F.tid; gid < 131072; gid += F.G * NWAVES * 64) {
        const int b = gid >> 16, q = gid & 65535, h = q >> 12;
        unsigned* p = (unsigned*)(Sst + (size_t)b * 128 * 131072 + 2 * q); const float* dc = cdec + (size_t)b * 128 * 16 + h;
        float r0 = 0.f, r1 = 0.f;
        for (int c0 = 0; c0 < 128; c0 += 8) { unsigned v[8]; float d[8];
#pragma unroll
            for (int i = 0; i < 8; ++i) { v[i] = p[(size_t)(c0 + i) * 65536]; d[i] = dc[(c0 + i) * 16]; }
#pragma unroll
            for (int i = 0; i < 8; ++i) { p[(size_t)(c0 + i) * 65536] = pk2(r0, r1); r0 = r0 * d[i] + bflo(v[i]); r1 = r1 * d[i] + bfhi(v[i]); } }
    }
}
__device__ __forceinline__ void ssd_passC(const Frame& F, const Args& a, bf16* proj, const bf16* Sst, float* ssqy) {
    LAS unsigned char* TC = F.lds; LAS unsigned char* TB = F.lds + 32768; LAS unsigned char* ST = F.lds;
    LAS unsigned char* TX0 = F.lds + 67584;
    LAS float* ACU = (LAS float*)(F.lds + 133120); LAS float* DTS = ACU + 512;
    const float* dtb = (const float*)(a.ws + WS_DT);
    const int lane = F.lane, wave = F.wave, hl = lane >> 5;
    for (int u = F.bid; u < 1024; u += F.G) {
        const int b = u >> 9, c = (u >> 2) & 127, hq = u & 3, g = hq >> 1;
        const size_t row0 = (size_t)b * SEQ + (size_t)c * 128;
        if (wave < 4) { const int hd = hq * 4 + wave; const float av = -__expf(a.in[7][hd]);
            const float dt0 = dtb[(row0 + 2 * lane) * 16 + hd], dt1 = dtb[(row0 + 2 * lane + 1) * 16 + hd];
            const float v0 = dt0 * av, v1 = dt1 * av; float incl = v0 + v1;
#pragma unroll
            for (int o = 1; o < 64; o <<= 1) { const float t = __shfl_up(incl, o); if (lane >= o) incl += t; }
            ACU[wave * 128 + 2 * lane] = incl - v1; ACU[wave * 128 + 2 * lane + 1] = incl; DTS[wave * 128 + 2 * lane] = dt0; DTS[wave * 128 + 2 * lane + 1] = dt1; }
        { const int cx = F.tid & 31, rr = F.tid >> 5; LAS unsigned char* TX = TX0 + (cx >> 4) * 32768;
          conv_run<8>(proj + row0 * PJ + C_X + hq * 256 + cx * 8, c * 128, rr * 8, a.in[4], a.in[5], hq * 256 + cx * 8,
              [&](int r, const float (&o)[8]) { v4u w; w.x = cvtpk(o[0], o[1]); w.y = cvtpk(o[2], o[3]); w.z = cvtpk(o[4], o[5]); w.w = cvtpk(o[6], o[7]); *(LAS v4u*)(TX + offb(r, cx & 15)) = w; }); }
        { const int cx = F.tid & 31, rr = F.tid >> 5; LAS unsigned char* TT = (cx < 16) ? TB : TC; const int cc = cx & 15; const int scol = (cx < 16 ? C_B : C_C) + g * 128 + cc * 8; const int cch = (cx < 16 ? 1024 : 1280) + g * 128 + cc * 8;
          conv_run<8>(proj + row0 * PJ + scol, c * 128, rr * 8, a.in[4], a.in[5], cch,
              [&](int r, const float (&o)[8]) { v4u w; w.x = cvtpk(o[0], o[1]); w.y = cvtpk(o[2], o[3]); w.z = cvtpk(o[4], o[5]); w.w = cvtpk(o[6], o[7]); *(LAS v4u*)(TT + offb(r, cc)) = w; }); }
        __syncthreads();
        const int lb = wave & 3, hh2 = wave >> 2; const int l = 32 * lb + (lane & 31);
        f32x16 Y[2][2];
        {
            const LAS unsigned char* TX = TX0 + hh2 * 32768;
#pragma unroll
            for (int e = 0; e < 2; ++e)
#pragma unroll
                for (int pb = 0; pb < 2; ++pb)
#pragma unroll
                    for (int r = 0; r < 16; ++r) Y[e][pb][r] = 0.f;
            const bf16* sp = Sst + (((size_t)b * 128 + c) * 16 + hq * 4 + 2 * hh2) * 8192 + (size_t)(lane & 31) * 128 + 8 * hl;
#pragma unroll 1
            for (int ks = 0; ks < 8; ++ks) { const bf16x8 cf = frag_row(TC, lb, ks, lane);
#pragma unroll
                for (int e = 0; e < 2; ++e) { const bf16x8 s0 = *(const bf16x8*)(sp + e * 8192 + 16 * ks), s1 = *(const bf16x8*)(sp + e * 8192 + 32 * 128 + 16 * ks);
                    Y[e][0] = MFMA32(s0, cf, Y[e][0]); Y[e][1] = MFMA32(s1, cf, Y[e][1]); } }
            float al[2];
#pragma unroll
            for (int e = 0; e < 2; ++e) { al[e] = ACU[(2 * hh2 + e) * 128 + l]; const float el = __expf(al[e]);
#pragma unroll
                for (int pb = 0; pb < 2; ++pb)
#pragma unroll
                    for (int r = 0; r < 16; ++r) Y[e][pb][r] *= el; }
#pragma unroll 1
            for (int sb = 0; sb <= lb; ++sb) {
                f32x16 GT;
#pragma unroll
                for (int r = 0; r < 16; ++r) GT[r] = 0.f;
#pragma unroll 2
                for (int ks = 0; ks < 8; ++ks) GT = MFMA32(frag_row(TB, sb, ks, lane), frag_row(TC, lb, ks, lane), GT);
#pragma unroll
                for (int s2 = 0; s2 < 2; ++s2)
#pragma unroll
                    for (int e = 0; e < 2; ++e) { const int hloc = 2 * hh2 + e; float v[8];
#pragma unroll
                        for (int j = 0; j < 8; ++j) { const int reg = 8 * s2 + j; const int s = 32 * sb + (reg & 3) + 8 * (reg >> 2) + 4 * hl;
                            const float as = ACU[hloc * 128 + s], ds = DTS[hloc * 128 + s];
                            v[j] = (s <= l) ? GT[reg] * __expf(fminf(al[e] - as, 0.f)) * ds : 0.f; }
                        v4u w; w.x = cvtpk(v[0], v[1]); w.y = cvtpk(v[2], v[3]); w.z = cvtpk(v[4], v[5]); w.w = cvtpk(v[6], v[7]);
                        const bf16x8 bfr = __builtin_bit_cast(bf16x8, w);
                        Y[e][0] = MFMA32(frag_tr<true>(TX, 2 * e + 0, 2 * sb + s2, lane), bfr, Y[e][0]);
                        Y[e][1] = MFMA32(frag_tr<true>(TX, 2 * e + 1, 2 * sb + s2, lane), bfr, Y[e][1]); }
            }
        }
        __syncthreads();
#pragma unroll
        for (int e = 0; e < 2; ++e)
#pragma unroll
            for (int pb = 0; pb < 2; ++pb)
#pragma unroll
                for (int q = 0; q < 4; ++q) { const int chl = (2 * hh2 + e) * 64 + 32 * pb + 8 * q + 4 * hl; v2u w; w.x = cvtpk(Y[e][pb][4 * q], Y[e][pb][4 * q + 1]); w.y = cvtpk(Y[e][pb][4 * q + 2], Y[e][pb][4 * q + 3]); *(LAS v2u*)(ST + l * 528 + chl * 2) = w; }
        __syncthreads();
        { const int cx = F.tid & 31, rq = F.tid >> 5; const float Dh = a.in[8][hq * 4 + (cx >> 3)]; const LAS unsigned char* TX = TX0 + (cx >> 4) * 32768;
#pragma unroll 2
          for (int i = 0; i < 8; ++i) { const int r = rq + 16 * i; float y[8], x[8], z[8];
              unpack8(*(const LAS v4u*)(ST + r * 528 + cx * 16), y); unpack8(*(const LAS v4u*)(TX + offb(r, cx & 15)), x);
              bf16* zp = proj + (row0 + r) * PJ + C_Z + hq * 256 + cx * 8; unpack8(*(const v4u*)zp, z);
              float o[8]; float ss = 0.f;
#pragma unroll
              for (int e = 0; e < 8; ++e) { o[e] = (y[e] + Dh * x[e]) * siluf_(z[e]); ss += o[e] * o[e]; }
              v4u w; w.x = cvtpk(o[0], o[1]); w.y = cvtpk(o[2], o[3]); w.z = cvtpk(o[4], o[5]); w.w = cvtpk(o[6], o[7]); *(v4u*)zp = w;
#pragma unroll
              for (int o2 = 1; o2 < 32; o2 <<= 1) ss += __shfl_xor(ss, o2);
              if (cx == 0) atomicAdd(ssqy + (row0 + r) * 2 + g, ss); } }
        __syncthreads();
    }
}
__device__ __forceinline__ void s_norms2(const Frame& F, bf16* proj, const float* ssqy) {
    const int gw = F.bid * NWAVES + F.wave, NGW = F.G * NWAVES;
    for (int m = gw; m < T; m += NGW) {
        bf16* pr = proj + (size_t)m * PJ;
#pragma unroll
        for (int g = 0; g < 2; ++g) { float x[8]; unpack8(*(const v4u*)(pr + C_Z + g * 512 + 8 * F.lane), x);
            const float r = 1.0f / sqrtf(ssqy[(size_t)m * 2 + g] * (1.f / 512.f) + EPS);
            v4u o; o.x = pk2(x[0] * r, x[1] * r); o.y = pk2(x[2] * r, x[3] * r); o.z = pk2(x[4] * r, x[5] * r); o.w = pk2(x[6] * r, x[7] * r);
            *(v4u*)(pr + C_Z + g * 512 + 8 * F.lane) = o; }
#pragma unroll
        for (int h = 0; h < 8; ++h) { const unsigned w = *(const unsigned*)(pr + C_Q + h * 128 + 2 * F.lane); const unsigned gt = *(const unsigned*)(pr + C_G + h * 128 + 2 * F.lane);
            const float o0 = bflo(w), o1 = bfhi(w);
            const float r = 1.0f / sqrtf(wave_sum(o0 * o0 + o1 * o1) * (1.f / 128.f) + EPS);
            *(unsigned*)(pr + C_G + h * 128 + 2 * F.lane) = pk2(o0 * r * siluf_(bflo(gt)), o1 * r * siluf_(bfhi(gt))); }
    }
}


struct HgGate { float bc[8][2], kk[8][2], tot[2], ref[2]; };
__device__ __forceinline__ void hg_gates(const Frame& F, const Args& a, const bf16* proj, size_t row0, int h, LAS float* SEG, HgGate& G) {
    const int kp = F.tid & 63, seg = F.tid >> 6, k0 = 2 * kp;
    const float* hlb = a.in[10];
    const float lb0 = sigmoidf_(hlb[h * 128 + k0] - hlb[1024 + h * 128 + k0]), lb1 = sigmoidf_(hlb[h * 128 + k0 + 1] - hlb[1024 + h * 128 + k0 + 1]);
    float c0 = 0.f, c1 = 0.f;
#pragma unroll
    for (int i = 0; i < 8; ++i) { const unsigned w = *(const unsigned*)(proj + (row0 + seg * 8 + i) * PJ + C_F + h * 128 + k0);
        const float f0 = lb0 + (1.f - lb0) * sigmoidf_(bflo(w)), f1 = lb1 + (1.f - lb1) * sigmoidf_(bfhi(w));
        c0 += __logf(f0); c1 += __logf(f1); G.bc[i][0] = c0; G.bc[i][1] = c1; G.kk[i][0] = 1.f - f0; G.kk[i][1] = 1.f - f1; }
    *(LAS f32x2*)(SEG + seg * 128 + k0) = (f32x2){c0, c1};
    __syncthreads();
    float o0 = 0.f, o1 = 0.f, t0 = 0.f, t1 = 0.f, r0 = 0.f, r1 = 0.f;
#pragma unroll
    for (int s2 = 0; s2 < 8; ++s2) { const f32x2 v = *(const LAS f32x2*)(SEG + s2 * 128 + k0); if (s2 < seg) { o0 += v.x; o1 += v.y; } if (s2 < 4) { r0 += v.x; r1 += v.y; } t0 += v.x; t1 += v.y; }
#pragma unroll
    for (int i = 0; i < 8; ++i) { G.bc[i][0] += o0; G.bc[i][1] += o1; }
    G.tot[0] = t0; G.tot[1] = t1; G.ref[0] = r0; G.ref[1] = r1;
}
__device__ __forceinline__ void hg_passA(const Frame& F, const Args& a, const bf16* proj, bf16* Hst, float* hdec) {
    LAS unsigned char* KD = F.lds; LAS unsigned char* TV = F.lds + 16384; LAS float* SEG = (LAS float*)(F.lds + 32768);
    const int lane = F.lane, wave = F.wave;
    for (int u = F.bid; u < 4096; u += F.G) {
        const int b = u >> 11, c = (u >> 3) & 255, h = u & 7; const size_t row0 = (size_t)b * SEQ + (size_t)c * 64;
        HgGate G; hg_gates(F, a, proj, row0, h, SEG, G);
        { const int kp = F.tid & 63, seg = F.tid >> 6, k0 = 2 * kp;
#pragma unroll
          for (int i = 0; i < 8; ++i) { const int j = seg * 8 + i; const float d0 = G.kk[i][0] * __expf(G.tot[0] - G.bc[i][0]), d1 = G.kk[i][1] * __expf(G.tot[1] - G.bc[i][1]);
              *(LAS unsigned*)(KD + offb(j, k0 >> 3) + (k0 & 7) * 2) = cvtpk(d0, d1); }
          if (seg == 0) *(f32x2*)(hdec + (((size_t)b * 256 + c) * 8 + h) * 128 + k0) = (f32x2){__expf(G.tot[0]), __expf(G.tot[1])}; }
#pragma unroll
        for (int i = 0; i < 2; ++i) { const int idx = F.tid + 512 * i, r = idx >> 4, ch = idx & 15; *(LAS v4u*)(TV + offb(r, ch)) = *(const v4u*)(proj + (row0 + r) * PJ + C_I + h * 128 + ch * 8); }
        __syncthreads();
        { const int vb = wave >> 1, kb0 = 2 * (wave & 1);
          f32x16 acc[2];
#pragma unroll
          for (int j = 0; j < 2; ++j)
#pragma unroll
              for (int r = 0; r < 16; ++r) acc[j][r] = 0.f;
#pragma unroll
          for (int ks = 0; ks < 4; ++ks) { const bf16x8 A = frag_tr<false>(TV, vb, ks, lane);
#pragma unroll
              for (int j = 0; j < 2; ++j) acc[j] = MFMA32(A, frag_tr<false>(KD, kb0 + j, ks, lane), acc[j]); }
          bf16* sp = Hst + (((size_t)b * 256 + c) * 8 + h) * 16384;
#pragma unroll
          for (int j = 0; j < 2; ++j)
#pragma unroll
              for (int r = 0; r < 16; ++r) { const int v = 32 * vb + (r & 3) + 8 * (r >> 2) + 4 * (lane >> 5), k = 32 * (kb0 + j) + (lane & 31); sp[v * 128 + k] = (bf16)f2bf(acc[j][r]); } }
        __syncthreads();
    }
}
__device__ __forceinline__ void hg_scan(const Frame& F, bf16* Hst, const float* hdec) {
    for (int gid = F.bid * (NWAVES * 64) + F.tid; gid < 131072; gid += F.G * NWAVES * 64) {
        const int b = gid >> 16, q = gid & 65535, h = q >> 13, k0 = (2 * q) & 127;
        unsigned* p = (unsigned*)(Hst + (size_t)b * 256 * 131072 + 2 * q); const float* dc = hdec + ((size_t)b * 256 * 8 + h) * 128 + k0;
        float r0 = 0.f, r1 = 0.f;
        for (int c0 = 0; c0 < 256; c0 += 8) { unsigned v[8]; f32x2 d[8];
#pragma unroll
            for (int i = 0; i < 8; ++i) { v[i] = p[(size_t)(c0 + i) * 65536]; d[i] = *(const f32x2*)(dc + (size_t)(c0 + i) * 1024); }
#pragma unroll
            for (int i = 0; i < 8; ++i) { p[(size_t)(c0 + i) * 65536] = pk2(r0, r1); r0 = r0 * d[i].x + bflo(v[i]); r1 = r1 * d[i].y + bfhi(v[i]); } }
    }
}
__device__ __forceinline__ void hg_passC(const Frame& F, const Args& a, bf16* proj, const bf16* Hst) {
    LAS unsigned char* QE = F.lds; LAS unsigned char* KE = F.lds + 16384; LAS unsigned char* QS = F.lds + 32768; LAS unsigned char* TV = F.lds + 49152; LAS unsigned char* SIN = F.lds + 65536;
    LAS float* SEG = (LAS float*)(F.lds + 98304); LAS unsigned char* OST = F.lds + 102400;
    const int lane = F.lane, wave = F.wave, hl = lane >> 5;
    for (int u = F.bid; u < 4096; u += F.G) {
        const int b = u >> 11, c = (u >> 3) & 255, h = u & 7; const size_t row0 = (size_t)b * SEQ + (size_t)c * 64;
        HgGate G; hg_gates(F, a, proj, row0, h, SEG, G);
        { const int kp = F.tid & 63, seg = F.tid >> 6, k0 = 2 * kp;
#pragma unroll
          for (int i = 0; i < 8; ++i) { const int j = seg * 8 + i; const unsigned w = *(const unsigned*)(proj + (row0 + j) * PJ + C_Q + h * 128 + k0);
              const float q0 = siluf_(bflo(w)), q1 = siluf_(bfhi(w)); const unsigned o = offb(j, k0 >> 3) + (k0 & 7) * 2;
              *(LAS unsigned*)(QE + o) = cvtpk(q0 * __expf(G.bc[i][0] - G.ref[0]), q1 * __expf(G.bc[i][1] - G.ref[1]));
              *(LAS unsigned*)(KE + o) = cvtpk(G.kk[i][0] * __expf(G.ref[0] - G.bc[i][0]), G.kk[i][1] * __expf(G.ref[1] - G.bc[i][1]));
              *(LAS unsigned*)(QS + o) = cvtpk(q0 * __expf(G.bc[i][0]), q1 * __expf(G.bc[i][1])); } }
#pragma unroll
        for (int i = 0; i < 2; ++i) { const int idx = F.tid + 512 * i, r = idx >> 4, ch = idx & 15; *(LAS v4u*)(TV + offb(r, ch)) = *(const v4u*)(proj + (row0 + r) * PJ + C_I + h * 128 + ch * 8); }
        { const bf16* sp = Hst + (((size_t)b * 256 + c) * 8 + h) * 16384;
#pragma unroll
          for (int i = 0; i < 4; ++i) { const int idx = F.tid + 512 * i, r = idx >> 4, ch = idx & 15; *(LAS v4u*)(SIN + offb(r, ch)) = *(const v4u*)(sp + r * 128 + ch * 8); } }
        __syncthreads();
        { const int vb = wave & 3, ib = wave >> 2; const int it = 32 * ib + (lane & 31);
          f32x16 acc;
#pragma unroll
          for (int r = 0; r < 16; ++r) acc[r] = 0.f;
#pragma unroll 2
          for (int ks = 0; ks < 8; ++ks) acc = MFMA32(frag_row(SIN, vb, ks, lane), frag_row(QS, ib, ks, lane), acc);
#pragma unroll 1
          for (int jb = 0; jb <= ib; ++jb) { f32x16 AT;
#pragma unroll
              for (int r = 0; r < 16; ++r) AT[r] = 0.f;
#pragma unroll 2
              for (int ks = 0; ks < 8; ++ks) AT = MFMA32(frag_row(KE, jb, ks, lane), frag_row(QE, ib, ks, lane), AT);
#pragma unroll
              for (int s2 = 0; s2 < 2; ++s2) { float v[8];
#pragma unroll
                  for (int j = 0; j < 8; ++j) { const int reg = 8 * s2 + j; const int jt = 32 * jb + (reg & 3) + 8 * (reg >> 2) + 4 * hl; v[j] = (jt <= it) ? AT[reg] : 0.f; }
                  v4u w; w.x = cvtpk(v[0], v[1]); w.y = cvtpk(v[2], v[3]); w.z = cvtpk(v[4], v[5]); w.w = cvtpk(v[6], v[7]);
                  acc = MFMA32(frag_tr<true>(TV, vb, 2 * jb + s2, lane), __builtin_bit_cast(bf16x8, w), acc); } }
#pragma unroll
          for (int q = 0; q < 4; ++q) *(LAS f32x4*)(OST + it * 528 + (32 * vb + 8 * q + 4 * hl) * 4) = (f32x4){acc[4 * q], acc[4 * q + 1], acc[4 * q + 2], acc[4 * q + 3]}; }
        __syncthreads();
        { const int i = F.tid >> 3, vg = F.tid & 7; float o[16]; float ss = 0.f;
#pragma unroll
          for (int q = 0; q < 4; ++q) { const f32x4 t = *(const LAS f32x4*)(OST + i * 528 + (vg * 16 + 4 * q) * 4); o[4 * q] = t.x; o[4 * q + 1] = t.y; o[4 * q + 2] = t.z; o[4 * q + 3] = t.w; ss += (t.x * t.x + t.y * t.y) + (t.z * t.z + t.w * t.w); }
          ss += __shfl_xor(ss, 1); ss += __shfl_xor(ss, 2); ss += __shfl_xor(ss, 4);
          const float rs = 1.0f / sqrtf(ss * (1.f / 128.f) + EPS);
          bf16* gp = proj + (row0 + i) * PJ + C_G + h * 128 + vg * 16;
#pragma unroll
          for (int hf = 0; hf < 2; ++hf) { float gt[8]; unpack8(*(const v4u*)(gp + 8 * hf), gt); v4u w;
              w.x = cvtpk(o[8 * hf + 0] * rs * siluf_(gt[0]), o[8 * hf + 1] * rs * siluf_(gt[1])); w.y = cvtpk(o[8 * hf + 2] * rs * siluf_(gt[2]), o[8 * hf + 3] * rs * siluf_(gt[3]));
              w.z = cvtpk(o[8 * hf + 4] * rs * siluf_(gt[4]), o[8 * hf + 5] * rs * siluf_(gt[5])); w.w = cvtpk(o[8 * hf + 6] * rs * siluf_(gt[6]), o[8 * hf + 7] * rs * siluf_(gt[7]));
              *(v4u*)(gp + 8 * hf) = w; } }
        __syncthreads();
    }
}
__device__ __forceinline__ void ssd_norm(const Frame& F, bf16* proj, const float* ssqy) {
    const int gw = F.bid * NWAVES + F.wave, NGW = F.G * NWAVES;
    for (int m = gw; m < T; m += NGW) {
        bf16* pr = proj + (size_t)m * PJ;
#pragma unroll
        for (int g = 0; g < 2; ++g) { float x[8]; unpack8(*(const v4u*)(pr + C_Z + g * 512 + 8 * F.lane), x);
            const float r = 1.0f / sqrtf(ssqy[(size_t)m * 2 + g] * (1.f / 512.f) + EPS);
            v4u o; o.x = cvtpk(x[0] * r, x[1] * r); o.y = cvtpk(x[2] * r, x[3] * r); o.z = cvtpk(x[4] * r, x[5] * r); o.w = cvtpk(x[6] * r, x[7] * r);
            *(v4u*)(pr + C_Z + g * 512 + 8 * F.lane) = o; }
    }
}


__device__ __forceinline__ void load_256sq(const Frame& F, LAS unsigned char* dst, const bf16* src) {
#pragma unroll 4
    for (int i = 0; i < 16; ++i) { const int idx = F.tid + 512 * i, r = idx >> 5, c16 = idx & 31; *(LAS v4u*)(dst + (c16 >> 4) * 65536 + offb(r, c16 & 15)) = *(const v4u*)(src + r * 256 + c16 * 8); }
}
__device__ __forceinline__ bf16x8 frag_row_perm(const LAS unsigned char* tile, int rb, int ks, int lane) {
    const int row = rb * 32 + (lane & 31), h = lane >> 5;
    const v2u a = *(const LAS v2u*)(tile + offb(row, 2 * ks) + 8 * h), b = *(const LAS v2u*)(tile + offb(row, 2 * ks + 1) + 8 * h);
    return __builtin_bit_cast(bf16x8, ((v4u){a.x, a.y, b.x, b.y}));
}
__device__ __forceinline__ void attn_phase(const Frame& F, const Args& a, bf16* proj) {
    const bf16* KM = (const bf16*)(a.ws + WS_KM); const bf16* VT = (const bf16*)(a.ws + WS_VT);
    LAS unsigned char* KV = F.lds;
    const int lane = F.lane, wave = F.wave, hl = lane >> 5;
    for (int u = F.bid; u < 512; u += F.G) {
        const int head = u >> 7, tile = u & 127, b = tile >> 6;
        const size_t rowq = (size_t)tile * 256 + wave * 32 + (lane & 31);
        const bf16* qp = proj + rowq * PJ + C_QA + head * 256 + 8 * hl;
        load_256sq(F, KV, KM + ((size_t)b * 4 + head) * 65536);
        __syncthreads();
        float mh[2], sh[2]; v4u P[8][2];
#pragma unroll
        for (int half = 0; half < 2; ++half) {
            f32x16 S[4];
#pragma unroll
            for (int kb = 0; kb < 4; ++kb)
#pragma unroll
                for (int r = 0; r < 16; ++r) S[kb][r] = 0.f;
#pragma unroll
            for (int kc = 0; kc < 4; ++kc) { bf16x8 qf[4];
#pragma unroll
                for (int ks = 0; ks < 4; ++ks) qf[ks] = *(const bf16x8*)(qp + kc * 64 + 16 * ks);
#pragma unroll
                for (int kb = 0; kb < 4; ++kb)
#pragma unroll
                    for (int ks = 0; ks < 4; ++ks) S[kb] = MFMA32(frag_row(KV + (kc >> 1) * 65536, half * 4 + kb, (kc & 1) * 4 + ks, lane), qf[ks], S[kb]); }
            float mx = -3.0e38f;
#pragma unroll
            for (int kb = 0; kb < 4; ++kb)
#pragma unroll
                for (int r = 0; r < 16; ++r) mx = fmaxf(mx, S[kb][r]);
            mx = fmaxf(mx, __shfl_xor(mx, 32));
            float sum = 0.f;
#pragma unroll
            for (int kb = 0; kb < 4; ++kb) {
#pragma unroll
                for (int r = 0; r < 16; ++r) { S[kb][r] = __expf(S[kb][r] - mx); sum += S[kb][r]; }
#pragma unroll
                for (int s2 = 0; s2 < 2; ++s2) { v4u w; w.x = cvtpk(S[kb][8 * s2], S[kb][8 * s2 + 1]); w.y = cvtpk(S[kb][8 * s2 + 2], S[kb][8 * s2 + 3]); w.z = cvtpk(S[kb][8 * s2 + 4], S[kb][8 * s2 + 5]); w.w = cvtpk(S[kb][8 * s2 + 6], S[kb][8 * s2 + 7]); P[half * 4 + kb][s2] = w; } }
            sum += __shfl_xor(sum, 32);
            mh[half] = mx; sh[half] = sum;
        }
        const float mt = fmaxf(mh[0], mh[1]); float c0 = __expf(mh[0] - mt), c1 = __expf(mh[1] - mt);
        { const float inv = 1.0f / (c0 * sh[0] + c1 * sh[1]); c0 *= inv; c1 *= inv; }
        __syncthreads();
        load_256sq(F, KV, VT + ((size_t)b * 4 + head) * 65536);
        __syncthreads();
        bf16* op = proj + rowq * PJ + C_OX + head * 256 + 4 * hl;
#pragma unroll 1
        for (int db = 0; db < 8; ++db) { f32x16 o0, o1;
#pragma unroll
            for (int r = 0; r < 16; ++r) { o0[r] = 0.f; o1[r] = 0.f; }
#pragma unroll
            for (int kb = 0; kb < 4; ++kb)
#pragma unroll
                for (int s2 = 0; s2 < 2; ++s2) { o0 = MFMA32(frag_row_perm(KV, db, kb * 2 + s2, lane), __builtin_bit_cast(bf16x8, P[kb][s2]), o0);
                    o1 = MFMA32(frag_row_perm(KV + 65536, db, kb * 2 + s2, lane), __builtin_bit_cast(bf16x8, P[4 + kb][s2]), o1); }
#pragma unroll
            for (int q = 0; q < 4; ++q) { v2u w; w.x = cvtpk(o0[4 * q] * c0 + o1[4 * q] * c1, o0[4 * q + 1] * c0 + o1[4 * q + 1] * c1); w.y = cvtpk(o0[4 * q + 2] * c0 + o1[4 * q + 2] * c1, o0[4 * q + 3] * c0 + o1[4 * q + 3] * c1); *(v2u*)(op + 32 * db + 8 * q) = w; } }
        __syncthreads();
    }
}

__global__ void __launch_bounds__(NWAVES * 64, 2) hybrid_fwd(Args args) {
    extern __shared__ __attribute__((aligned(16))) unsigned char lds[];
    Frame F;
    F.lds = (LAS unsigned char*)lds;
    F.tid = threadIdx.x; F.lane = F.tid & 63; F.wave = __builtin_amdgcn_readfirstlane(F.tid >> 6);
    F.G = gridDim.x; F.bid = blockIdx.x;
    unsigned char* ws = args.ws;
    unsigned* ctl = (unsigned*)(ws + WS_CTL);
    for (int u = F.tid; u < (LDS_BYTES - LDSCTL_OFF) / 4; u += NWAVES * 64) ((LAS unsigned*)(F.lds + LDSCTL_OFF))[u] = 0u;
    __syncthreads();
    XcdBarrier bar = xcd_barrier_post(ctl + CW_BAR, (volatile LAS unsigned*)(F.lds + MISC_OFF) + 8);
#define GRID_BAR() xcd_barrier(bar)
    bf16* proj = (bf16*)(ws + WS_PROJ);
    float* ssq1 = (float*)(ctl + CW_SSQ1); float* ssq2 = (float*)(ctl + CW_SSQ2); float* ssq3 = (float*)(ctl + CW_SSQ3);

    p0_prologue(F, args);
    GRID_BAR();
    { pg8::Gemm g{(const bf16*)args.out, D, (const bf16*)(ws + WS_WIN), T, PJ, D}; pg8::StaticOrder S; S.init(T, PJ, F.G, F.bid);
      pg8::EpiScaleBf16<0> E{proj, PJ, (const float*)(ws + WS_RSTD0)};
      pg8::gemm_phase<pg8::EpiScaleBf16<0>, pg8::StaticOrder, true, true>(F.lds + RING_OFF, g, S, E); }
    GRID_BAR();
    float* ssqy = (float*)(ctl + CW_SSQY); float* cdec = (float*)(ws + WS_CDEC); float* hdec = (float*)(ws + WS_HDEC); bf16* Sst = (bf16*)(ws + WS_SST); bf16* Hst = (bf16*)args.out;
    ssd_passA(F, args, proj, Sst, cdec);
    hg_passA(F, args, proj, Hst, hdec);
    GRID_BAR();
    ssd_scan(F, Sst, cdec);
    hg_scan(F, Hst, hdec);
    GRID_BAR();
    ssd_passC(F, args, proj, Sst, ssqy);
    hg_passC(F, args, proj, Hst);
    GRID_BAR();
    ssd_norm(F, proj, ssqy);
    GRID_BAR();
    { pg8::Gemm g{proj + C_Z, PJ, (const bf16*)(ws + WS_WOUT), T, D, 2048}; pg8::StaticOrder S; S.init(T, D, F.G, F.bid);
      pg8::EpiRes E{args.in[0], args.out, proj + C_X1B, PJ, ssq1};
      pg8::gemm_phase<pg8::EpiRes, pg8::StaticOrder, true, true>(F.lds + RING_OFF, g, S, E); }
    GRID_BAR();
    { pg8::Gemm g{proj + C_X1B, PJ, (const bf16*)(ws + WS_WQ), T, D, D}; pg8::StaticOrder S; S.init(T, D, F.G, F.bid);
      pg8::EpiScaleBf16<1> E{proj + C_QA, PJ, ssq1};
      pg8::gemm_phase<pg8::EpiScaleBf16<1>, pg8::StaticOrder, true, true>(F.lds + RING_OFF, g, S, E); }
    GRID_BAR();
    attn_phase(F, args, proj);
    GRID_BAR();
    { pg8::Gemm g{proj + C_OX, PJ, (const bf16*)(ws + WS_WO), T, D, D}; pg8::StaticOrder S; S.init(T, D, F.G, F.bid);
      pg8::EpiRes E{args.out, args.out, proj + C_X2B, PJ, ssq2};
      pg8::gemm_phase<pg8::EpiRes, pg8::StaticOrder, true, true>(F.lds + RING_OFF, g, S, E); }
    GRID_BAR();
    { pg8::Gemm g{proj + C_X2B, PJ, (const bf16*)(ws + WS_WGU), T, 2 * FF, D}; pg8::StaticOrder S; S.init(T, 2 * FF, F.G, F.bid);
      pg8::EpiSwiglu E{proj + C_ACT, PJ, ssq2};
      pg8::gemm_phase<pg8::EpiSwiglu, pg8::StaticOrder, true, true>(F.lds + RING_OFF, g, S, E); }
    GRID_BAR();
    { pg8::Gemm g{proj + C_ACT, PJ, (const bf16*)(ws + WS_WD), T, D, FF}; pg8::StaticOrder S; S.init(T, D, F.G, F.bid);
      pg8::EpiRes E{args.out, args.out, proj + C_X2B, PJ, ssq3};
      pg8::gemm_phase<pg8::EpiRes, pg8::StaticOrder, true, true>(F.lds + RING_OFF, g, S, E); }
    GRID_BAR();
    s_final(F, args, ssq3);
}

extern "C" void kernel_launch(void* const* d_in, const int* in_sizes, int n_in, void* d_out, int out_size, void* d_ws, size_t ws_size, hipStream_t stream) {
    static int grid = 0;
    if (grid == 0) {
        if (n_in != 23 || in_sizes[0] != T * D || out_size != T * D || ws_size < WS_END) { fprintf(stderr, "kernel_launch: unexpected shapes / workspace (n_in %d, ws %zu, need %zu)\n", n_in, ws_size, (size_t)WS_END); grid = -1; return; }
        int dev = 0, cus = 0, per_cu = 0;
        if (hipGetDevice(&dev) != hipSuccess || hipDeviceGetAttribute(&cus, hipDeviceAttributeMultiprocessorCount, dev) != hipSuccess) { grid = -1; return; }
        if (hipFuncSetAttribute((const void*)hybrid_fwd, hipFuncAttributeMaxDynamicSharedMemorySize, LDS_BYTES) != hipSuccess) { fprintf(stderr, "kernel_launch: hipFuncSetAttribute failed\n"); grid = -1; return; }
        if (hipOccupancyMaxActiveBlocksPerMultiprocessor(&per_cu, (const void*)hybrid_fwd, NWAVES * 64, LDS_BYTES) != hipSuccess || per_cu < 1) { fprintf(stderr, "kernel_launch: occupancy query says %d blocks per CU\n", per_cu); }
        (void)hipGetLastError();
        grid = cus;
    }
    if (grid < 0) return;
    if (hipMemsetAsync((char*)d_ws + WS_CTL, 0, CTL_ZERO_BYTES, stream) != hipSuccess) return;
    Args a{};
    for (int i = 0; i < 23; ++i) a.in[i] = (const float*)d_in[i];
    a.out = (float*)d_out; a.ws = (unsigned char*)d_ws;
    hipLaunchKernelGGL(hybrid_fwd, dim3(grid), dim3(NWAVES * 64), LDS_BYTES, stream, a);
}
```

```cpp
#include <hip/hip_runtime.h>
#include <cstdio>
#include <cstdint>

#define GAS __attribute__((address_space(1)))
#define LAS __attribute__((address_space(3)))
typedef unsigned short bf16;
typedef unsigned v4u __attribute__((ext_vector_type(4)));
typedef unsigned v2u __attribute__((ext_vector_type(2)));
typedef float f32x4 __attribute__((ext_vector_type(4)));
typedef float f32x2 __attribute__((ext_vector_type(2)));
typedef short bf16x8 __attribute__((ext_vector_type(8)));
typedef GAS unsigned gu32;

constexpr int BATCH = 2, SEQ = 16384, D = 1024, T = BATCH * SEQ;
constexpr int MEMLEN = 256, NIN = 6672, FF = 2816;
constexpr float EPS = 1e-6f;
constexpr int PJ = 6656;
constexpr int C_Z = 0, C_G = 1024, C_X = 2048, C_B = 3072, C_C = 3328, C_Q = 3584, C_F = 4608, C_I = 5632;
constexpr int C_X1B = 2048, C_QA = 3072, C_OX = 4096, C_X2B = 5120, C_ACT = 0;

constexpr size_t MiB = 1u << 20;
constexpr size_t WS_CTL = 0, CTL_ZERO_BYTES = 1 * MiB;
constexpr int CW_BAR = 4096;
constexpr int CW_SSQ1 = 32768, CW_SSQ2 = CW_SSQ1 + T, CW_SSQ3 = CW_SSQ2 + T;
constexpr int CW_SSQY = CW_SSQ3 + T;
static_assert((size_t)(CW_SSQY + 2 * T) * 4 <= CTL_ZERO_BYTES, "ctl");
constexpr size_t WS_DT = 1 * MiB;
constexpr size_t WS_KM = 3 * MiB;
constexpr size_t WS_VT = 4 * MiB;
constexpr size_t WS_HDEC = 5 * MiB;
constexpr size_t WS_CDEC = 7 * MiB;
constexpr size_t WS_RSTD0 = 7 * MiB + 65536;
constexpr size_t WS_WOUT = 7 * MiB + 512 * 1024;
constexpr size_t WS_WQ = WS_WOUT + 4 * MiB;
constexpr size_t WS_WO = WS_WQ + 2 * MiB;
constexpr size_t WS_WGU = WS_WO + 2 * MiB;
constexpr size_t WS_WD = WS_WGU + 11 * MiB;
constexpr size_t WS_PROJ = 32 * MiB;
constexpr size_t WS_R = 448 * MiB;
constexpr size_t WS_WIN = WS_R;
constexpr size_t WS_SST = WS_R;
constexpr size_t WS_END = 512 * MiB;
static_assert(WS_WD + (size_t)1024 * FF * 2 <= WS_PROJ && WS_PROJ + (size_t)T * PJ * 2 <= WS_R, "ws");
static_assert(WS_END <= 512 * MiB, "ws");

constexpr int NWAVES = 8;
constexpr int RING_OFF = 0, RING_BYTES = 131072;
constexpr int LDS_BYTES = 147456;
constexpr int LDSCTL_OFF = LDS_BYTES - 1024, MISC_OFF = LDSCTL_OFF;

#define RLX_AGENT __ATOMIC_RELAXED, __HIP_MEMORY_SCOPE_AGENT
#define LDS_WAIT() asm volatile("s_waitcnt lgkmcnt(0)" ::: "memory")
#define VM_WAIT() asm volatile("s_waitcnt vmcnt(0)" ::: "memory")
__device__ __forceinline__ unsigned f2bf(float f) { unsigned u = __builtin_bit_cast(unsigned, f); return (u + 0x7fffu + ((u >> 16) & 1u)) >> 16; }
__device__ __forceinline__ unsigned pk2(float lo, float hi) { return f2bf(lo) | (f2bf(hi) << 16); }
__device__ __forceinline__ float bf2f(unsigned b) { return __builtin_bit_cast(float, b << 16); }
__device__ __forceinline__ float bflo(unsigned w) { return __builtin_bit_cast(float, w << 16); }
__device__ __forceinline__ float bfhi(unsigned w) { return __builtin_bit_cast(float, w & 0xffff0000u); }
__device__ __forceinline__ float sigmoidf_(float x) { return __builtin_amdgcn_rcpf(1.f + __builtin_amdgcn_exp2f(-1.44269504089f * x)); }
__device__ __forceinline__ float siluf_(float x) { return x * __builtin_amdgcn_rcpf(1.f + __builtin_amdgcn_exp2f(-1.44269504089f * x)); }
__device__ __forceinline__ float softplusf_(float x) { return x > 20.f ? x : log1pf(__expf(x)); }
__device__ __forceinline__ float wave_sum(float v) {
#pragma unroll
    for (int o = 1; o < 64; o <<= 1) v += __shfl_xor(v, o);
    return v;
}
__device__ __forceinline__ float wave_max(float v) {
#pragma unroll
    for (int o = 1; o < 64; o <<= 1) v = fmaxf(v, __shfl_xor(v, o));
    return v;
}

#define XB_TMO      128
#define XB_XCNT(j)  (256  + 64 * (j))
#define XB_XSUB(j)  (1280 + 64 * (j))
#define XB_XGEN(j)  (2304 + 64 * (j))
#define XB_TOP      3328
#define XB_TOPGEN   3392
#define XCD_BAR_WORDS 3456
#define XB_SPIN_CAP (1u << 22)
__device__ __forceinline__ unsigned xb_ld(unsigned* p)              { return __hip_atomic_load(p, __ATOMIC_RELAXED, __HIP_MEMORY_SCOPE_AGENT); }
__device__ __forceinline__ unsigned xb_add(unsigned* p, unsigned v) { return __hip_atomic_fetch_add(p, v, __ATOMIC_RELAXED, __HIP_MEMORY_SCOPE_AGENT); }
__device__ __forceinline__ unsigned xb_xcc_id() { return (unsigned)__builtin_amdgcn_s_getreg((3 << 11) | 20) & 0xFu; }
#define XB_SPIN(cond, bar) do { unsigned _sp = 0; while (cond) { __builtin_amdgcn_s_sleep(1); \
    if ((++_sp & 255u) == 0u) { if (xb_ld(&(bar)[XB_TMO])) break; if (_sp > XB_SPIN_CAP) { atomicAdd(&(bar)[XB_TMO], 1u); break; } } } } while (0)
struct XcdBarrier { unsigned* bar; unsigned x; volatile LAS unsigned* st; };
__device__ __forceinline__ XcdBarrier xcd_barrier_post(unsigned* bar, volatile LAS unsigned* st) {
    XcdBarrier b; b.bar = bar; b.x = xb_xcc_id(); b.st = st;
    if (threadIdx.x == 0) (void)xb_add(&bar[XB_XCNT(b.x)], 1u);
    return b;
}
__device__ __forceinline__ void xcd_barrier_complete(unsigned* bar, unsigned x, unsigned& nloc, unsigned& nx) {
    const unsigned G = gridDim.x * gridDim.y * gridDim.z;
    unsigned sum, cnt, mine, sp = 0u;
    for (;;) {
        sum = 0u; cnt = 0u; mine = 0u;
#pragma unroll
        for (unsigned j = 0; j < 16; ++j) { const unsigned c = xb_ld(&bar[XB_XCNT(j)]); sum += c; cnt += (c > 0u) ? 1u : 0u; mine = (j == x) ? c : mine; }
        if (sum == G) break;
        __builtin_amdgcn_s_sleep(1);
        if ((++sp & 255u) == 0u) { if (xb_ld(&bar[XB_TMO])) break; if (sp > XB_SPIN_CAP) { atomicAdd(&bar[XB_TMO], 1u); break; } }
    }
    nloc = mine > 0u ? mine : 1u; nx = cnt > 0u ? cnt : 1u;
}
__device__ __forceinline__ void xcd_barrier(const XcdBarrier& b) {
    asm volatile("s_waitcnt vmcnt(0)" ::: "memory");
    __syncthreads();
    if (threadIdx.x == 0) {
        unsigned* bar = b.bar;
        __builtin_amdgcn_s_waitcnt(0);
        unsigned nloc = b.st[0], nx = b.st[1];
        if (nloc == 0u) { xcd_barrier_complete(bar, b.x, nloc, nx); b.st[0] = nloc; b.st[1] = nx; }
        const unsigned old = xb_add(&bar[XB_XSUB(b.x)], 1u);
        const unsigned gen = old / nloc;
        if (old + 1u == (gen + 1u) * nloc) {
            __builtin_amdgcn_fence(__ATOMIC_RELEASE, "agent");
            asm volatile("s_waitcnt vmcnt(0)" ::: "memory");
            const unsigned og = xb_add(&bar[XB_TOP], 1u);
            const unsigned tg = og / nx;
            if (og + 1u == (tg + 1u) * nx) xb_add(&bar[XB_TOPGEN], 1u);
            else XB_SPIN(xb_ld(&bar[XB_TOPGEN]) == tg, bar);
            __builtin_amdgcn_fence(__ATOMIC_ACQUIRE, "agent");
            xb_add(&bar[XB_XGEN(b.x)], 1u);
            asm volatile("s_waitcnt vmcnt(0)" ::: "memory");
        } else {
            XB_SPIN(xb_ld(&bar[XB_XGEN(b.x)]) == gen, bar);
            __builtin_amdgcn_fence(__ATOMIC_ACQUIRE, "agent");
            asm volatile("s_waitcnt vmcnt(0)" ::: "memory");
        }
    }
    __syncthreads();
}

namespace pg8 {
#define PG8_LAS __attribute__((address_space(3)))
typedef unsigned short bf16_t;
typedef unsigned u32x4 __attribute__((ext_vector_type(4)));
constexpr int BM = 256, BK = 64, HALF = 128, HTB = HALF * BK * 2, STAGE_BYTES = 8 * HTB, NXCD = 8, WGM = 8;
__host__ __device__ __forceinline__ int lds_byte(int r, int c) { const int st = (r >> 4) * 2 + (c >> 5), rr = r & 15, cc = c & 31, ob = rr * 64 + cc * 2; return st * 1024 + (ob ^ (((ob >> 9) & 1) << 5)); }
__host__ __device__ __forceinline__ void stage_rc(int b, int& R, int& C) { const int st = b / 1024, sb = b % 1024, swz = sb ^ (((sb >> 9) & 1) << 5); R = (st >> 1) * 16 + swz / 64; C = (st & 1) * 32 + (swz % 64) / 2; }
__host__ __device__ __forceinline__ int perm32(int rho) { const int n = rho >> 4, i = rho & 15; return 8 * (i >> 2) + 4 * n + (i & 3); }
struct Unit { int pm, pn; };
struct Gemm { const bf16_t* A; int lda; const bf16_t* Bt; int M, N, K; };
struct StaticOrder {
    int nM, nN, nwg, G, c;
    __host__ __device__ void init(int M, int N, int G_, int c_) { nM = M / BM; nN = N / BM; nwg = nM * nN; G = G_; c = c_; }
    __host__ __device__ bool next(int i, Unit& u) const {
        const long L = (long)i * G + c; if (L >= nwg) return false;
        int wgid = (int)L; { const int q = nwg / NXCD, r = nwg % NXCD, xcd = wgid % NXCD, off = wgid / NXCD; wgid = (xcd < r ? xcd * (q + 1) : r * (q + 1) + (xcd - r) * q) + off; }
        const int nig = WGM * nN, gid = wgid / nig, fm = gid * WGM, gsz = (nM - fm) < WGM ? (nM - fm) : WGM;
        u.pm = fm + ((wgid % nig) % gsz); u.pn = (wgid % nig) / gsz; return true;
    }
    __device__ __forceinline__ void a_ready(const Unit&) const {}
    __device__ __forceinline__ void done(const Unit&) const {}
};
__device__ __forceinline__ unsigned cvt_pk_bf16(float lo, float hi) { unsigned r; asm volatile("v_cvt_pk_bf16_f32 %0, %1, %2" : "=v"(r) : "v"(lo), "v"(hi)); return r; }

template <int MODE> struct EpiScaleBf16 {
    static constexpr bool PERM = true, AFTER_DRAIN = false;
    bf16_t* O; int ldc; const float* rs;
    __device__ __forceinline__ void operator()(const f32x4 (&acc)[2][2][4][2], const Unit& u, int wr, int wc, int fr, int fq) const {
        const int row0 = u.pm * BM + wr * 64 + fr; const int col0 = u.pn * BM + wc * 32 + 8 * fq;
#pragma unroll
        for (int ai = 0; ai < 2; ++ai)
#pragma unroll
            for (int m = 0; m < 4; ++m) { const int row = row0 + ai * HALF + m * 16; float sc = rs[row]; if (MODE == 1) sc = 1.0f / sqrtf(sc * (1.0f / 1024.0f) + 1e-6f);
                bf16_t* rowp = O + (size_t)row * ldc + col0;
#pragma unroll
                for (int bj = 0; bj < 2; ++bj) { const f32x4 v0 = acc[ai][bj][m][0] * sc, v1 = acc[ai][bj][m][1] * sc; u32x4 w;
                    w.x = cvt_pk_bf16(v0[0], v0[1]); w.y = cvt_pk_bf16(v0[2], v0[3]); w.z = cvt_pk_bf16(v1[0], v1[1]); w.w = cvt_pk_bf16(v1[2], v1[3]);
                    *(u32x4*)(rowp + bj * HALF) = w; } }
    }
};
struct EpiProj {
    static constexpr bool PERM = true, AFTER_DRAIN = false;
    bf16_t* O; int ldc; const float* rs; const float* hlb;
    __device__ __forceinline__ void operator()(const f32x4 (&acc)[2][2][4][2], const Unit& u, int wr, int wc, int fr, int fq) const {
        const int row0 = u.pm * BM + wr * 64 + fr; const int col0 = u.pn * BM + wc * 32 + 8 * fq;
        const int mode = (u.pn < 8 || (u.pn >= 14 && u.pn < 18)) ? 1 : ((u.pn >= 18 && u.pn < 22) ? 2 : 0);
        float lb[2][8];
        if (mode == 2) {
#pragma unroll
            for (int bj = 0; bj < 2; ++bj)
#pragma unroll
                for (int i = 0; i < 8; ++i) { const int k = col0 + bj * HALF + i - 4608; const float d = hlb[k] - hlb[1024 + k]; lb[bj][i] = __builtin_amdgcn_rcpf(1.f + __builtin_amdgcn_exp2f(-1.44269504089f * d)); }
        }
#pragma unroll
        for (int ai = 0; ai < 2; ++ai)
#pragma unroll
            for (int m = 0; m < 4; ++m) { const int row = row0 + ai * HALF + m * 16; const float sc = rs[row];
                bf16_t* rowp = O + (size_t)row * ldc + col0;
#pragma unroll
                for (int bj = 0; bj < 2; ++bj) { float v[8];
#pragma unroll
                    for (int i = 0; i < 4; ++i) { v[i] = acc[ai][bj][m][0][i] * sc; v[4 + i] = acc[ai][bj][m][1][i] * sc; }
                    if (mode == 1) {
#pragma unroll
                        for (int i = 0; i < 8; ++i) v[i] = v[i] * __builtin_amdgcn_rcpf(1.f + __builtin_amdgcn_exp2f(-1.44269504089f * v[i]));
                    } else if (mode == 2) {
#pragma unroll
                        for (int i = 0; i < 8; ++i) { const float sg = __builtin_amdgcn_rcpf(1.f + __builtin_amdgcn_exp2f(-1.44269504089f * v[i])); v[i] = __builtin_amdgcn_logf(lb[bj][i] + (1.f - lb[bj][i]) * sg); }
                    }
                    u32x4 w; w.x = cvt_pk_bf16(v[0], v[1]); w.y = cvt_pk_bf16(v[2], v[3]); w.z = cvt_pk_bf16(v[4], v[5]); w.w = cvt_pk_bf16(v[6], v[7]);
                    *(u32x4*)(rowp + bj * HALF) = w; } }
    }
};
struct EpiSwiglu {
    static constexpr bool PERM = true, AFTER_DRAIN = false;
    bf16_t* O; int ldc; const float* ssq;
    __device__ __forceinline__ void operator()(const f32x4 (&acc)[2][2][4][2], const Unit& u, int wr, int wc, int fr, int fq) const {
        const int row0 = u.pm * BM + wr * 64 + fr; const int col0 = u.pn * HALF + wc * 32 + 8 * fq;
#pragma unroll
        for (int ai = 0; ai < 2; ++ai)
#pragma unroll
            for (int m = 0; m < 4; ++m) { const int row = row0 + ai * HALF + m * 16; const float sc = 1.0f / sqrtf(ssq[row] * (1.0f / 1024.0f) + 1e-6f);
                float o[8];
#pragma unroll
                for (int n = 0; n < 2; ++n)
#pragma unroll
                    for (int i = 0; i < 4; ++i) { const float g = acc[ai][0][m][n][i] * sc, up = acc[ai][1][m][n][i] * sc; o[n * 4 + i] = g / (1.0f + __expf(-g)) * up; }
                u32x4 w; w.x = cvt_pk_bf16(o[0], o[1]); w.y = cvt_pk_bf16(o[2], o[3]); w.z = cvt_pk_bf16(o[4], o[5]); w.w = cvt_pk_bf16(o[6], o[7]);
                *(u32x4*)(O + (size_t)row * ldc + col0) = w; }
    }
};
struct EpiRes {
    static constexpr bool PERM = false, AFTER_DRAIN = false;
    const float* xold; float* xnew; bf16_t* XB; int ldb; float* ssq;
    __device__ __forceinline__ void operator()(const f32x4 (&acc)[2][2][4][2], const Unit& u, int wr, int wc, int fr, int fq) const {
        const int row0 = u.pm * BM + wr * 64 + fr; const int col0 = u.pn * BM + wc * 32 + 4 * fq;
#pragma unroll
        for (int ai = 0; ai < 2; ++ai)
#pragma unroll
            for (int m = 0; m < 4; ++m) { const int row = row0 + ai * HALF + m * 16; const size_t off = (size_t)row * 1024 + col0; float s = 0.f;
#pragma unroll
                for (int bj = 0; bj < 2; ++bj)
#pragma unroll
                    for (int n = 0; n < 2; ++n) { const f32x4 xo = *(const f32x4*)(xold + off + bj * HALF + n * 16); const f32x4 xn = xo + acc[ai][bj][m][n];
                        *(f32x4*)(xnew + off + bj * HALF + n * 16) = xn; s += (xn[0] * xn[0] + xn[1] * xn[1]) + (xn[2] * xn[2] + xn[3] * xn[3]);
                        v2u w; w.x = cvt_pk_bf16(xn[0], xn[1]); w.y = cvt_pk_bf16(xn[2], xn[3]);
                        *(v2u*)(XB + (size_t)row * ldb + col0 + bj * HALF + n * 16) = w; }
                s += __shfl_xor(s, 16); s += __shfl_xor(s, 32);
                if (fq == 0) atomicAdd(ssq + row, s);
                if (m & 1) asm volatile("" ::: "memory"); }
    }
};

template <class Epi, class Sched, bool ALIGN_EPI = false, bool SP2 = false>
__device__ __forceinline__ void gemm_phase(PG8_LAS unsigned char* lds, const Gemm g, const Sched& S, const Epi& E) {
    int tid_ = threadIdx.x; asm volatile("" : "+v"(tid_));
    const int tid = tid_, wid = __builtin_amdgcn_readfirstlane(tid >> 6), lane = tid & 63, wr = wid >> 2, wc = wid & 3, fr = lane & 15, fq = lane >> 4;
    const int K = g.K, nt = K / BK, lda = g.lda;
    unsigned voffA[2], voffB[2];
#pragma unroll
    for (int i = 0; i < 2; ++i) { int R, C; stage_rc(tid * 16 + i * 8192, R, C); const int Rb = Epi::PERM ? ((R & ~31) + perm32(R & 31)) : R;
        voffA[i] = (unsigned)(R * lda + C) * 2u; voffB[i] = (unsigned)(Rb * K + C) * 2u; }
    const size_t kstep = (size_t)(BK * 2);
    const size_t hstepA = (size_t)HALF * lda * 2, hstepB = (size_t)HALF * K * 2;
    const size_t tstepA = 2 * hstepA, tstepB = 2 * hstepB;
    const unsigned ldsw = (unsigned)wid * 1024u;
    const int aoff = lds_byte(wr * 64 + fr, fq * 8), boff = lds_byte(wc * 32 + fr, fq * 8);
#define PG8_SA(b, h) (((b) * 2 + (h)) * HTB)
#define PG8_SB(b, h) ((4 + (b) * 2 + (h)) * HTB)
#define PG8_STAGE(bufoff, gbase, voff) do { _Pragma("unroll") for (int _i = 0; _i < 2; ++_i) \
        __builtin_amdgcn_global_load_lds((const unsigned*)((const char*)(gbase) + (voff)[_i]), (PG8_LAS unsigned*)(lds + (bufoff) + ldsw + _i * 8192), 16, 0, 0); } while (0)
#define PG8_LDA(dst, b, h) do { _Pragma("unroll") for (int m = 0; m < 4; ++m) _Pragma("unroll") for (int k = 0; k < 2; ++k) dst[m][k] = *(const PG8_LAS bf16x8*)(lds + PG8_SA(b, h) + aoff + m * 2048 + k * 1024); } while (0)
#define PG8_LDB(dst, b, h) do { _Pragma("unroll") for (int n = 0; n < 2; ++n) _Pragma("unroll") for (int k = 0; k < 2; ++k) dst[n][k] = *(const PG8_LAS bf16x8*)(lds + PG8_SB(b, h) + boff + n * 2048 + k * 1024); } while (0)
#define PG8_MMA(ai, bj, At, Bt) do { __builtin_amdgcn_s_setprio(1); _Pragma("unroll") for (int m = 0; m < 4; ++m) _Pragma("unroll") for (int n = 0; n < 2; ++n) _Pragma("unroll") for (int k = 0; k < 2; ++k) \
        acc[ai][bj][m][n] = __builtin_amdgcn_mfma_f32_16x16x32_bf16(Bt[n][k], At[m][k], acc[ai][bj][m][n], 0, 0, 0); __builtin_amdgcn_s_setprio(0); } while (0)
#define PG8_WAIT_V(n) asm volatile("s_waitcnt vmcnt(" #n ")" ::: "memory")
#define PG8_WAIT_L(n) asm volatile("s_waitcnt lgkmcnt(" #n ")" ::: "memory")
#define PG8_BAR __builtin_amdgcn_s_barrier()
#define PG8_SCHED __builtin_amdgcn_sched_barrier(0)
    Unit cur, nxt; int ui = 0;
    if (!S.next(0, cur)) return;
    f32x4 acc[2][2][4][2];
#pragma unroll
    for (int a = 0; a < 2; ++a)
#pragma unroll
        for (int b = 0; b < 2; ++b)
#pragma unroll
            for (int m = 0; m < 4; ++m)
#pragma unroll
                for (int n = 0; n < 2; ++n) acc[a][b][m][n] = (f32x4){0.f, 0.f, 0.f, 0.f};
    bf16x8 At[4][2], B0[2][2], B1[2][2];
    const char* cA = (const char*)g.A + (size_t)cur.pm * tstepA; const char* cB = (const char*)g.Bt + (size_t)cur.pn * tstepB;
    S.a_ready(cur);
    if constexpr (SP2) {
        PG8_STAGE(PG8_SB(0, 0), cB, voffB); PG8_STAGE(PG8_SB(0, 1), cB + hstepB, voffB); PG8_STAGE(PG8_SA(0, 0), cA, voffA); PG8_STAGE(PG8_SA(0, 1), cA + hstepA, voffA);
        if (wr == 1) PG8_BAR;
        PG8_WAIT_V(2); PG8_BAR;
        PG8_STAGE(PG8_SB(1, 0), cB + kstep, voffB); PG8_STAGE(PG8_SA(1, 0), cA + kstep, voffA); PG8_STAGE(PG8_SB(1, 1), cB + hstepB + kstep, voffB);
        PG8_WAIT_V(6); PG8_BAR;
    } else {
        PG8_STAGE(PG8_SB(0, 0), cB, voffB); PG8_STAGE(PG8_SA(0, 0), cA, voffA); PG8_STAGE(PG8_SB(0, 1), cB + hstepB, voffB); PG8_STAGE(PG8_SA(0, 1), cA + hstepA, voffA);
        if (wr == 1) PG8_BAR;
        PG8_WAIT_V(4); PG8_BAR;
        PG8_STAGE(PG8_SB(1, 0), cB + kstep, voffB); PG8_STAGE(PG8_SA(1, 0), cA + kstep, voffA); PG8_STAGE(PG8_SB(1, 1), cB + hstepB + kstep, voffB);
        PG8_WAIT_V(6); PG8_BAR;
    }
    for (;;) {
        const bool has_next = S.next(ui + 1, nxt);
        const char* nA = has_next ? (const char*)g.A + (size_t)nxt.pm * tstepA : cA; const char* nB = has_next ? (const char*)g.Bt + (size_t)nxt.pn * tstepB : cB;
        for (int t = 0; t < nt; t += 2) {
            const bool last = (t == nt - 2);
            const char* a1 = cA + (size_t)(t + 1) * kstep;
            const char* a2 = last ? nA : cA + (size_t)(t + 2) * kstep; const char* b2 = last ? nB : cB + (size_t)(t + 2) * kstep;
            const char* a3 = a2 + kstep; const char* b3 = b2 + kstep;
            if (last && has_next) S.a_ready(nxt);
            if constexpr (SP2) {
            PG8_LDB(B0, 0, 0); PG8_LDB(B1, 0, 1); PG8_SCHED; PG8_LDA(At, 0, 0); PG8_STAGE(PG8_SA(1, 1), a1 + hstepA, voffA);
            PG8_WAIT_V(8); PG8_WAIT_L(0); PG8_BAR; PG8_MMA(0, 0, At, B0); PG8_MMA(0, 1, At, B1); PG8_BAR; PG8_SCHED;
            PG8_LDA(At, 0, 1); PG8_STAGE(PG8_SB(0, 0), b2, voffB); PG8_STAGE(PG8_SB(0, 1), b2 + hstepB, voffB); PG8_STAGE(PG8_SA(0, 0), a2, voffA);
            PG8_WAIT_V(8); PG8_WAIT_L(0); PG8_BAR; PG8_MMA(1, 0, At, B0); PG8_MMA(1, 1, At, B1); PG8_BAR; PG8_SCHED;
            PG8_LDB(B0, 1, 0); PG8_LDB(B1, 1, 1); PG8_SCHED; PG8_LDA(At, 1, 0); PG8_STAGE(PG8_SA(0, 1), a2 + hstepA, voffA);
            PG8_WAIT_V(8); PG8_WAIT_L(0); PG8_BAR; PG8_MMA(0, 0, At, B0); PG8_MMA(0, 1, At, B1); PG8_BAR; PG8_SCHED;
            PG8_LDA(At, 1, 1); PG8_STAGE(PG8_SB(1, 0), b3, voffB); PG8_STAGE(PG8_SB(1, 1), b3 + hstepB, voffB); PG8_STAGE(PG8_SA(1, 0), a3, voffA);
            PG8_WAIT_V(8); PG8_WAIT_L(0); PG8_BAR; PG8_MMA(1, 0, At, B0); PG8_MMA(1, 1, At, B1); PG8_BAR; PG8_SCHED;
            } else {
            PG8_LDB(B0, 0, 0); PG8_SCHED; PG8_LDA(At, 0, 0); PG8_STAGE(PG8_SA(1, 1), a1 + hstepA, voffA);
            PG8_WAIT_L(8); PG8_BAR; PG8_WAIT_L(0); PG8_MMA(0, 0, At, B0); PG8_BAR; PG8_SCHED;
            PG8_LDB(B1, 0, 1); PG8_STAGE(PG8_SB(0, 0), b2, voffB);
            PG8_BAR; PG8_WAIT_L(0); PG8_MMA(0, 1, At, B1); PG8_BAR;
            PG8_LDA(At, 0, 1); PG8_STAGE(PG8_SA(0, 0), a2, voffA);
            PG8_BAR; PG8_WAIT_L(0); PG8_MMA(1, 0, At, B0); PG8_BAR; PG8_SCHED;
            PG8_STAGE(PG8_SB(0, 1), b2 + hstepB, voffB);
            PG8_WAIT_V(6); PG8_BAR; PG8_MMA(1, 1, At, B1); PG8_BAR;
            PG8_LDB(B0, 1, 0); PG8_SCHED; PG8_LDA(At, 1, 0); PG8_STAGE(PG8_SA(0, 1), a2 + hstepA, voffA);
            PG8_WAIT_L(8); PG8_BAR; PG8_WAIT_L(0); PG8_MMA(0, 0, At, B0); PG8_BAR; PG8_SCHED;
            PG8_LDB(B1, 1, 1); PG8_STAGE(PG8_SB(1, 0), b3, voffB);
            PG8_BAR; PG8_WAIT_L(0); PG8_MMA(0, 1, At, B1); PG8_BAR;
            PG8_LDA(At, 1, 1); PG8_STAGE(PG8_SA(1, 0), a3, voffA);
            PG8_BAR; PG8_WAIT_L(0); PG8_MMA(1, 0, At, B0); PG8_BAR; PG8_SCHED;
            PG8_STAGE(PG8_SB(1, 1), b3 + hstepB, voffB);
            PG8_WAIT_V(6); PG8_BAR; PG8_MMA(1, 1, At, B1); PG8_BAR;
            }
        }
        if constexpr (ALIGN_EPI) { if (wr == 0) PG8_BAR; }
        if constexpr (!Epi::AFTER_DRAIN) { E(acc, cur, wr, wc, fr, fq); S.done(cur); }
        if (!has_next) break;
#pragma unroll
        for (int a = 0; a < 2; ++a)
#pragma unroll
            for (int b = 0; b < 2; ++b)
#pragma unroll
                for (int m = 0; m < 4; ++m)
#pragma unroll
                    for (int n = 0; n < 2; ++n) acc[a][b][m][n] = (f32x4){0.f, 0.f, 0.f, 0.f};
        cur = nxt; cA = nA; cB = nB; ++ui;
        if constexpr (ALIGN_EPI) { if (wr == 1) PG8_BAR; }
    }
    PG8_WAIT_V(0);
    if constexpr (!ALIGN_EPI) { if (wr == 0) PG8_BAR; }
    PG8_BAR;
#undef PG8_SA
#undef PG8_SB
#undef PG8_STAGE
#undef PG8_LDA
#undef PG8_LDB
#undef PG8_MMA
#undef PG8_WAIT_V
#undef PG8_WAIT_L
#undef PG8_BAR
#undef PG8_SCHED
}
}

struct Args { const float* in[23]; float* out; unsigned char* ws; };
struct Frame {
    LAS unsigned char* lds;
    int tid, lane, wave, G, bid;
};

__device__ __forceinline__ void p0_transpose_item(const float* W, int ldw, int col0, int K, bf16* WT, int dst_row0, int k0, const float* ks, float mul, LAS float* scr, int lane) {
    float tv[32];
#pragma unroll
    for (int i = 0; i < 32; ++i) tv[i] = W[(size_t)(k0 + 2 * i + (lane >> 5)) * ldw + col0 + (lane & 31)];
#pragma unroll
    for (int i = 0; i < 32; ++i) { const int kk = 2 * i + (lane >> 5); float v = tv[i]; if (ks) v *= ks[kk]; scr[kk * 33 + (lane & 31)] = v * mul; }
    LDS_WAIT(); asm volatile("" ::: "memory");
    const int c = lane & 7;
#pragma unroll
    for (int j = 0; j < 4; ++j) { const int n = (lane >> 3) + 8 * j; const LAS float* s = scr + (8 * c) * 33 + n;
        v4u o; o.x = pk2(s[0 * 33], s[1 * 33]); o.y = pk2(s[2 * 33], s[3 * 33]); o.z = pk2(s[4 * 33], s[5 * 33]); o.w = pk2(s[6 * 33], s[7 * 33]);
        *(v4u*)(WT + (size_t)(dst_row0 + n) * K + k0 + 8 * c) = o; }
    LDS_WAIT(); asm volatile("" ::: "memory");
}

__device__ __forceinline__ void p0_prologue(const Frame& F, const Args& a) {
    unsigned char* ws = a.ws;
    const int gw = F.bid * NWAVES + F.wave, NGW = F.G * NWAVES;
    {
        LAS float* scr = (LAS float*)(F.lds + F.wave * 8704);
        bf16* WinT = (bf16*)(ws + WS_WIN); bf16* WoutT = (bf16*)(ws + WS_WOUT); bf16* WqT = (bf16*)(ws + WS_WQ); bf16* WoT = (bf16*)(ws + WS_WO); bf16* WguT = (bf16*)(ws + WS_WGU); bf16* WdT = (bf16*)(ws + WS_WD);
        constexpr int I_IN = 16 * (PJ / 32);
        constexpr int I_OUT = 32 * 32, I_Q = 16 * 32, I_O = 16 * 32, I_G = 16 * 88, I_U = 16 * 88, I_D = 44 * 32;
        constexpr int NITEMS = I_IN + I_OUT + I_Q + I_O + I_G + I_U + I_D;
        for (int it = gw; it < NITEMS; it += NGW) {
            int r = it;
            if (r < I_IN) { const int nblk = PJ / 32, kb = r / nblk, nb = r % nblk, drow = nb * 32;
                int scol;
                if (drow < 1024) scol = drow;
                else if (drow < 2048) scol = 5648 + (drow - 1024);
                else if (drow < 3584) scol = 1024 + (drow - 2048);
                else if (drow < 4608) scol = 2576 + (drow - 3584);
                else if (drow < 5632) scol = 3600 + (drow - 4608);
                else scol = 4624 + (drow - 5632);
                p0_transpose_item(a.in[3], NIN, scol, 1024, WinT, drow, kb * 64, a.in[2] + kb * 64, 1.f, scr, F.lane); continue; }
            r -= I_IN;
            if (r < I_OUT) { const int kb = r / 32, nb = r % 32, k0 = kb * 64; const float* ks = (k0 < 1024) ? a.in[9] + k0 : a.in[11] + ((k0 - 1024) & 127);
                p0_transpose_item(a.in[12], 1024, nb * 32, 2048, WoutT, nb * 32, k0, ks, 1.f, scr, F.lane); continue; }
            r -= I_OUT;
            if (r < I_Q) { const int kb = r / 32, nb = r % 32; p0_transpose_item(a.in[15], 1024, nb * 32, 1024, WqT, nb * 32, kb * 64, a.in[13] + kb * 64, 0.0625f, scr, F.lane); continue; }
            r -= I_Q;
            if (r < I_O) { const int kb = r / 32, nb = r % 32; p0_transpose_item(a.in[17], 1024, nb * 32, 1024, WoT, nb * 32, kb * 64, nullptr, 1.f, scr, F.lane); continue; }
            r -= I_O;
            if (r < I_G) { const int kb = r / 88, nb = r % 88, c0 = nb * 32; p0_transpose_item(a.in[19], FF, c0, 1024, WguT, (c0 >> 7) * 256 + (c0 & 127), kb * 64, a.in[18] + kb * 64, 1.f, scr, F.lane); continue; }
            r -= I_G;
            if (r < I_U) { const int kb = r / 88, nb = r % 88, c0 = nb * 32; p0_transpose_item(a.in[20], FF, c0, 1024, WguT, (c0 >> 7) * 256 + 128 + (c0 & 127), kb * 64, a.in[18] + kb * 64, 1.f, scr, F.lane); continue; }
            r -= I_U;
            { const int kb = r / 32, nb = r % 32; p0_transpose_item(a.in[21], 1024, nb * 32, FF, WdT, nb * 32, kb * 64, nullptr, 1.f, scr, F.lane); }
        }
    }
    __syncthreads();
    LAS float* wdt = (LAS float*)(F.lds);
    for (int i = F.tid; i < 16 * 1024; i += NWAVES * 64) { const int k = i >> 4, c = i & 15; wdt[c * 1024 + k] = a.in[3][(size_t)k * NIN + 2560 + c] * a.in[2][k]; }
    __syncthreads();
    {
        bf16* XB = (bf16*)a.out; float* rstd0 = (float*)(ws + WS_RSTD0); float* dtb = (float*)(ws + WS_DT);
        for (int m = gw; m < T; m += NGW) {
            const f32x4* xr = (const f32x4*)(a.in[0] + (size_t)m * D) + F.lane;
            f32x4 v[4]; float s = 0.f;
#pragma unroll
            for (int j = 0; j < 4; ++j) { v[j] = xr[64 * j]; s += (v[j].x * v[j].x + v[j].y * v[j].y) + (v[j].z * v[j].z + v[j].w * v[j].w); }
            const float rstd = 1.0f / sqrtf(wave_sum(s) * (1.f / D) + EPS);
            unsigned long long* o8 = (unsigned long long*)(XB + (size_t)m * D) + F.lane;
#pragma unroll
            for (int j = 0; j < 4; ++j) o8[64 * j] = (unsigned long long)pk2(v[j].x, v[j].y) | ((unsigned long long)pk2(v[j].z, v[j].w) << 32);
            float dd[16];
#pragma unroll 4
            for (int c = 0; c < 16; ++c) { float d = 0.f;
#pragma unroll
                for (int j = 0; j < 4; ++j) { const f32x4 w = *(const LAS f32x4*)(wdt + c * 1024 + 256 * j + 4 * F.lane); d += (v[j].x * w.x + v[j].y * w.y) + (v[j].z * w.z + v[j].w * w.w); }
                dd[c] = d; }
            float e8[8], e4[4], e2[2], mydt;
            { const bool up = (F.lane & 32) != 0;
#pragma unroll
              for (int i = 0; i < 8; ++i) { const float snd = up ? dd[i] : dd[i + 8], kp = up ? dd[i + 8] : dd[i]; e8[i] = kp + __shfl_xor(snd, 32); } }
            { const bool up = (F.lane & 16) != 0;
#pragma unroll
              for (int i = 0; i < 4; ++i) { const float snd = up ? e8[i] : e8[i + 4], kp = up ? e8[i + 4] : e8[i]; e4[i] = kp + __shfl_xor(snd, 16); } }
            { const bool up = (F.lane & 8) != 0;
#pragma unroll
              for (int i = 0; i < 2; ++i) { const float snd = up ? e4[i] : e4[i + 2], kp = up ? e4[i + 2] : e4[i]; e2[i] = kp + __shfl_xor(snd, 8); } }
            { const bool up = (F.lane & 4) != 0; const float snd = up ? e2[0] : e2[1], kp = up ? e2[1] : e2[0]; mydt = kp + __shfl_xor(snd, 4); }
            mydt += __shfl_xor(mydt, 1); mydt += __shfl_xor(mydt, 2);
            const int myc = ((F.lane >> 5) & 1) * 8 + ((F.lane >> 4) & 1) * 4 + ((F.lane >> 3) & 1) * 2 + ((F.lane >> 2) & 1);
            if (F.lane == 0) rstd0[m] = rstd;
            if ((F.lane & 3) == 0) dtb[(size_t)m * 16 + myc] = softplusf_(mydt * rstd + a.in[6][myc]);
        }
    }
}

__device__ __forceinline__ void s_conv(const Frame& F, const Args& a, const bf16* proj, bf16* XC) {
    const float* cw = a.in[4]; const float* cb = a.in[5];
    const size_t total = (size_t)T * 1536;
    for (size_t i = (size_t)F.bid * (NWAVES * 64) + F.tid; i < total; i += (size_t)F.G * NWAVES * 64) {
        const int row = (int)(i / 1536), ch = (int)(i % 1536), t = row & (SEQ - 1);
        float acc = cb[ch];
#pragma unroll
        for (int k = 0; k < 4; ++k) { const int tt = t - 3 + k; if (tt >= 0) acc += cw[k * 1536 + ch] * bf2f(proj[(size_t)(row - 3 + k) * PJ + C_X + ch]); }
        XC[i] = (bf16)f2bf(siluf_(acc));
    }
}
__device__ __forceinline__ void s_scan(const Frame& F, const Args& a, bf16* proj, const bf16* XC) {
    const float* dtb = (const float*)(a.ws + WS_DT);
    LAS float* sm = (LAS float*)F.lds;
    if (F.bid < 32) {
        const int b = F.bid >> 4, h = F.bid & 15, g = h >> 3, p = F.tid & 63, nq = F.tid >> 6;
        const float av = -__expf(a.in[7][h]), Dh = a.in[8][h];
        float st[16];
#pragma unroll
        for (int i = 0; i < 16; ++i) st[i] = 0.f;
        for (int t = 0; t < SEQ; ++t) {
            const size_t row = (size_t)b * SEQ + t;
            const float dt = dtb[row * 16 + h], dA = __expf(dt * av);
            const float xv = bf2f(XC[row * 1536 + h * 64 + p]);
            const bf16* Bp = XC + row * 1536 + 1024 + g * 128 + nq * 16; const bf16* Cp = Bp + 256;
            const float dx = dt * xv; float part = 0.f;
#pragma unroll
            for (int i = 0; i < 16; ++i) { st[i] = st[i] * dA + dx * bf2f(Bp[i]); part += st[i] * bf2f(Cp[i]); }
            LAS float* yb = sm + (t & 1) * 512;
            yb[nq * 64 + p] = part;
            __syncthreads();
            if (nq == 0) { float y = Dh * xv;
#pragma unroll
                for (int q = 0; q < 8; ++q) y += yb[q * 64 + p];
                bf16* zp = proj + row * PJ + C_Z + h * 64 + p; const float z = bf2f(*zp); *zp = (bf16)f2bf(y * siluf_(z)); }
        }
    }
}
__device__ __forceinline__ void s_scan_hg(const Frame& F, const Args& a, bf16* proj) {
    LAS float* sm = (LAS float*)F.lds;
    if (F.bid < 16) {
        const int bb = F.bid, b = bb >> 3, h = bb & 7, v = F.tid & 127, kq = F.tid >> 7;
        float lbv = 0.f; if (F.tid < 128) lbv = sigmoidf_(a.in[10][h * 128 + F.tid] - a.in[10][1024 + h * 128 + F.tid]);
        float S[32];
#pragma unroll
        for (int i = 0; i < 32; ++i) S[i] = 0.f;
        for (int t = 0; t < SEQ; ++t) {
            const size_t row = (size_t)b * SEQ + t;
            LAS float* fb = sm + 1024 + (t & 1) * 256; LAS float* qb = fb + 128; LAS float* pb = sm + 2048 + (t & 1) * 512;
            if (F.tid < 128) { const float hf = bf2f(proj[row * PJ + C_F + h * 128 + F.tid]), hq = bf2f(proj[row * PJ + C_Q + h * 128 + F.tid]);
                fb[F.tid] = lbv + (1.f - lbv) * sigmoidf_(hf); qb[F.tid] = siluf_(hq); }
            const float iv = bf2f(proj[row * PJ + C_I + h * 128 + v]);
            __syncthreads();
            float part = 0.f;
#pragma unroll
            for (int i = 0; i < 32; ++i) { const float f = fb[kq * 32 + i]; S[i] = f * S[i] + (1.f - f) * iv; part += S[i] * qb[kq * 32 + i]; }
            pb[kq * 128 + v] = part;
            __syncthreads();
            if (kq == 0) { const float o = (pb[v] + pb[128 + v]) + (pb[256 + v] + pb[384 + v]); proj[row * PJ + C_Q + h * 128 + v] = (bf16)f2bf(o); }
        }
    }
}
__device__ __forceinline__ void s_norms(const Frame& F, bf16* proj) {
    const int gw = F.bid * NWAVES + F.wave, NGW = F.G * NWAVES;
    for (int m = gw; m < T; m += NGW) {
        bf16* pr = proj + (size_t)m * PJ;
#pragma unroll
        for (int g = 0; g < 2; ++g) { v4u w = *(const v4u*)(pr + C_Z + g * 512 + 8 * F.lane); float x[8] = {bflo(w.x), bfhi(w.x), bflo(w.y), bfhi(w.y), bflo(w.z), bfhi(w.z), bflo(w.w), bfhi(w.w)};
            float s = 0.f;
#pragma unroll
            for (int i = 0; i < 8; ++i) s += x[i] * x[i];
            const float r = 1.0f / sqrtf(wave_sum(s) * (1.f / 512.f) + EPS);
            v4u o; o.x = pk2(x[0] * r, x[1] * r); o.y = pk2(x[2] * r, x[3] * r); o.z = pk2(x[4] * r, x[5] * r); o.w = pk2(x[6] * r, x[7] * r);
            *(v4u*)(pr + C_Z + g * 512 + 8 * F.lane) = o; }
#pragma unroll
        for (int h = 0; h < 8; ++h) { const unsigned w = *(const unsigned*)(pr + C_Q + h * 128 + 2 * F.lane); const unsigned gt = *(const unsigned*)(pr + C_G + h * 128 + 2 * F.lane);
            const float o0 = bflo(w), o1 = bfhi(w);
            const float r = 1.0f / sqrtf(wave_sum(o0 * o0 + o1 * o1) * (1.f / 128.f) + EPS);
            *(unsigned*)(pr + C_G + h * 128 + 2 * F.lane) = pk2(o0 * r * siluf_(bflo(gt)), o1 * r * siluf_(bfhi(gt))); }
    }
}
__device__ __forceinline__ void s_attn(const Frame& F, const Args& a, bf16* proj) {
    const bf16* KM = (const bf16*)(a.ws + WS_KM); const bf16* VT = (const bf16*)(a.ws + WS_VT);
    LAS float* qs = (LAS float*)F.lds + F.wave * 512; LAS float* ps = qs + 256;
    const int gw = F.bid * NWAVES + F.wave, NGW = F.G * NWAVES;
    for (int it = gw; it < T * 4; it += NGW) {
        const int row = it >> 2, h = it & 3, b = row >> 14;
        { const v2u w = *(const v2u*)(proj + (size_t)row * PJ + C_QA + h * 256 + 4 * F.lane); qs[4 * F.lane] = bflo(w.x); qs[4 * F.lane + 1] = bfhi(w.x); qs[4 * F.lane + 2] = bflo(w.y); qs[4 * F.lane + 3] = bfhi(w.y); }
        LDS_WAIT(); asm volatile("" ::: "memory");
        float s[4];
#pragma unroll
        for (int kk = 0; kk < 4; ++kk) { const bf16* kr = KM + (((size_t)b * 4 + h) * 256 + (F.lane + 64 * kk)) * 256; float acc = 0.f;
            for (int d = 0; d < 256; d += 8) { const v4u w = *(const v4u*)(kr + d);
                acc += qs[d] * bflo(w.x) + qs[d + 1] * bfhi(w.x) + qs[d + 2] * bflo(w.y) + qs[d + 3] * bfhi(w.y) + qs[d + 4] * bflo(w.z) + qs[d + 5] * bfhi(w.z) + qs[d + 6] * bflo(w.w) + qs[d + 7] * bfhi(w.w); }
            s[kk] = acc; }
        const float mx = wave_max(fmaxf(fmaxf(s[0], s[1]), fmaxf(s[2], s[3])));
        float sum = 0.f;
#pragma unroll
        for (int kk = 0; kk < 4; ++kk) { s[kk] = __expf(s[kk] - mx); sum += s[kk]; }
        const float inv = 1.0f / wave_sum(sum);
#pragma unroll
        for (int kk = 0; kk < 4; ++kk) ps[F.lane + 64 * kk] = s[kk] * inv;
        LDS_WAIT(); asm volatile("" ::: "memory");
#pragma unroll
        for (int j = 0; j < 4; ++j) { const int d = F.lane + 64 * j; const bf16* vr = VT + (((size_t)b * 4 + h) * 256 + d) * 256; float acc = 0.f;
            for (int k = 0; k < 256; k += 8) { const v4u w = *(const v4u*)(vr + k);
                acc += ps[k] * bflo(w.x) + ps[k + 1] * bfhi(w.x) + ps[k + 2] * bflo(w.y) + ps[k + 3] * bfhi(w.y) + ps[k + 4] * bflo(w.z) + ps[k + 5] * bfhi(w.z) + ps[k + 6] * bflo(w.w) + ps[k + 7] * bfhi(w.w); }
            proj[(size_t)row * PJ + C_OX + h * 256 + d] = (bf16)f2bf(acc); }
        LDS_WAIT(); asm volatile("" ::: "memory");
    }
}
template <bool DRY = false> __device__ __forceinline__ void s_final(const Frame& F, const Args& a, const float* ssq) {
    const int gw = F.bid * NWAVES + F.wave, NGW = F.G * NWAVES;
    for (int m = gw; m < T; m += NGW) {
        const float r = 1.0f / sqrtf(ssq[m] * (1.f / D) + EPS);
        f32x4* xr = (f32x4*)(a.out + (size_t)m * D) + F.lane; const f32x4* wr = (const f32x4*)a.in[22] + F.lane;
#pragma unroll
        for (int j = 0; j < 4; ++j) { f32x4 v = xr[64 * j]; const f32x4 w = wr[64 * j]; v = v * r * w; if (!DRY || r == -1.f) xr[64 * j] = v; }
    }
}


typedef float f32x16 __attribute__((ext_vector_type(16)));
typedef short s16x4 __attribute__((ext_vector_type(4)));
__device__ __forceinline__ unsigned cvtpk(float lo, float hi) { unsigned r; asm volatile("v_cvt_pk_bf16_f32 %0, %1, %2" : "=v"(r) : "v"(lo), "v"(hi)); return r; }
__device__ __forceinline__ unsigned offb(unsigned row, unsigned ch) { return 256u * row + 16u * (ch ^ (((row & 3u) << 2) | ((row >> 2) & 3u))); }
__device__ __forceinline__ bf16x8 frag_row(const LAS unsigned char* tile, int rb, int ks, int lane) { return *(const LAS bf16x8*)(tile + offb(rb * 32 + (lane & 31), 2 * ks + (lane >> 5))); }
template <bool PERM> __device__ __forceinline__ bf16x8 frag_tr(const LAS unsigned char* tile, int c, int ks, int lane) {
    const int h = lane >> 5, blk = (lane >> 4) & 1, q = (lane & 15) >> 2, p = lane & 3;
    const int r0 = 16 * ks + (PERM ? 4 * h : 8 * h) + q, r1 = r0 + (PERM ? 8 : 4);
    const unsigned chn = 4 * c + 2 * blk + (p >> 1);
    const s16x4 a = __builtin_amdgcn_ds_read_tr16_b64_v4i16((LAS s16x4*)(tile + offb(r0, chn) + 8 * (p & 1)));
    const s16x4 b = __builtin_amdgcn_ds_read_tr16_b64_v4i16((LAS s16x4*)(tile + offb(r1, chn) + 8 * (p & 1)));
    return (bf16x8){a[0], a[1], a[2], a[3], b[0], b[1], b[2], b[3]};
}
#define MFMA32(A, B, C) __builtin_amdgcn_mfma_f32_32x32x16_bf16(A, B, C, 0, 0, 0)
__device__ __forceinline__ void unpack8(const v4u w, float (&x)[8]) { x[0] = bflo(w.x); x[1] = bfhi(w.x); x[2] = bflo(w.y); x[3] = bfhi(w.y); x[4] = bflo(w.z); x[5] = bfhi(w.z); x[6] = bflo(w.w); x[7] = bfhi(w.w); }

template <int R> struct ConvIn { v4u t[R + 3]; };
template <int R> __device__ __forceinline__ void conv_load(ConvIn<R>& ci, const bf16* src, int tseq0, int r0) {
    const v4u zero = {0u, 0u, 0u, 0u};
#pragma unroll
    for (int i = 0; i < 3; ++i) ci.t[i] = (tseq0 + r0 - 3 + i >= 0) ? *(const v4u*)(src + (ptrdiff_t)(r0 - 3 + i) * PJ) : zero;
#pragma unroll
    for (int i = 0; i < R; ++i) ci.t[3 + i] = *(const v4u*)(src + (ptrdiff_t)(r0 + i) * PJ);
}
template <int R, class Sink> __device__ __forceinline__ void conv_apply(const ConvIn<R>& ci, int r0, const float* cw, const float* cb, int cch, Sink&& sink) {
    float w[4][8], bias[8];
#pragma unroll
    for (int k = 0; k < 4; ++k) { const f32x4 a0 = *(const f32x4*)(cw + k * 1536 + cch), a1 = *(const f32x4*)(cw + k * 1536 + cch + 4);
        w[k][0] = a0.x; w[k][1] = a0.y; w[k][2] = a0.z; w[k][3] = a0.w; w[k][4] = a1.x; w[k][5] = a1.y; w[k][6] = a1.z; w[k][7] = a1.w; }
    { const f32x4 a0 = *(const f32x4*)(cb + cch), a1 = *(const f32x4*)(cb + cch + 4); bias[0] = a0.x; bias[1] = a0.y; bias[2] = a0.z; bias[3] = a0.w; bias[4] = a1.x; bias[5] = a1.y; bias[6] = a1.z; bias[7] = a1.w; }
    float p3[8], p2[8], p1[8], cur[8];
    unpack8(ci.t[0], p3); unpack8(ci.t[1], p2); unpack8(ci.t[2], p1);
#pragma unroll
    for (int i = 0; i < R; ++i) {
        unpack8(ci.t[3 + i], cur);
        float o[8];
#pragma unroll
        for (int e = 0; e < 8; ++e) { const float acc = bias[e] + w[0][e] * p3[e] + w[1][e] * p2[e] + w[2][e] * p1[e] + w[3][e] * cur[e]; o[e] = siluf_(acc); p3[e] = p2[e]; p2[e] = p1[e]; p1[e] = cur[e]; }
        sink(r0 + i, o);
    }
}


__device__ __forceinline__ void p0_kv(const Frame& F, const Args& a) {
    bf16* KM = (bf16*)(a.ws + WS_KM); bf16* VT = (bf16*)(a.ws + WS_VT);
    LAS unsigned char* AI = F.lds; LAS unsigned char* BI = F.lds + 32768; LAS float* RS = (LAS float*)(F.lds + 98304);
    const int lane = F.lane, wave = F.wave;
    const float* nw = a.in[14];
    for (int u = F.bid; u < 256; u += F.G) {
        const int mt = u >> 5, nt = u & 31, m0 = mt * 64, n0 = nt * 64;
        __syncthreads();
#pragma unroll 2
        for (int i = 0; i < 8; ++i) { const f32x4* xr = (const f32x4*)(a.in[1] + (size_t)(m0 + wave * 8 + i) * D) + lane; float ss = 0.f;
#pragma unroll
            for (int j = 0; j < 4; ++j) { const f32x4 v = xr[64 * j]; ss += (v.x * v.x + v.y * v.y) + (v.z * v.z + v.w * v.w); }
            ss = wave_sum(ss); if (lane == 0) RS[wave * 8 + i] = 1.0f / sqrtf(ss * (1.f / D) + EPS); }
        f32x16 acc;
#pragma unroll
        for (int r = 0; r < 16; ++r) acc[r] = 0.f;
#pragma unroll 1
        for (int kt = 0; kt < 4; ++kt) { const int k0 = kt * 256;
            f32x4 av[8], bv[8];
            { const int r = F.tid >> 3, cs = F.tid & 7; const f32x4* ap = (const f32x4*)(a.in[1] + (size_t)(m0 + r) * D + k0 + cs * 32);
#pragma unroll
              for (int i = 0; i < 8; ++i) av[i] = ap[i];
              const int kr = F.tid >> 1, hf = F.tid & 1; const f32x4* bp = (const f32x4*)(a.in[16] + (size_t)(k0 + kr) * 2048 + n0 + hf * 32);
#pragma unroll
              for (int i = 0; i < 8; ++i) bv[i] = bp[i];
              const f32x4* wp = (const f32x4*)(nw + k0 + cs * 32);
#pragma unroll
              for (int i = 0; i < 4; ++i) { const f32x4 w0 = wp[2 * i], w1 = wp[2 * i + 1]; const f32x4 x0 = av[2 * i] * w0, x1 = av[2 * i + 1] * w1; v4u o; o.x = cvtpk(x0.x, x0.y); o.y = cvtpk(x0.z, x0.w); o.z = cvtpk(x1.x, x1.y); o.w = cvtpk(x1.z, x1.w);
                  const int ch = cs * 4 + i; *(LAS v4u*)(AI + (ch >> 4) * 16384 + offb(r, ch & 15)) = o; }
#pragma unroll
              for (int i = 0; i < 4; ++i) { const f32x4 x0 = bv[2 * i], x1 = bv[2 * i + 1]; v4u o; o.x = cvtpk(x0.x, x0.y); o.y = cvtpk(x0.z, x0.w); o.z = cvtpk(x1.x, x1.y); o.w = cvtpk(x1.z, x1.w);
                  *(LAS v4u*)(BI + offb(kr, hf * 4 + i)) = o; } }
            __syncthreads();
            if (wave < 4) { const int mb = wave >> 1, nb = wave & 1;
#pragma unroll 4
                for (int ks = 0; ks < 16; ++ks) acc = MFMA32(frag_row(AI + (ks >> 3) * 16384, mb, ks & 7, lane), frag_tr<false>(BI, nb, ks, lane), acc); }
            __syncthreads();
        }
        if (wave < 4) { const int mb = wave >> 1, nb = wave & 1; const int n = n0 + 32 * nb + (lane & 31);
#pragma unroll
            for (int q = 0; q < 4; ++q) { const int mr = 32 * mb + 8 * q + 4 * (lane >> 5); const int m = m0 + mr, bb = m >> 8, key = m & 255;
                float v[4];
#pragma unroll
                for (int e = 0; e < 4; ++e) v[e] = acc[4 * q + e] * RS[mr + e];
                if (n < 1024) { const int h = n >> 8, d = n & 255;
#pragma unroll
                    for (int e = 0; e < 4; ++e) KM[(((size_t)bb * 4 + h) * 256 + key + e) * 256 + d] = (bf16)f2bf(v[e]); }
                else { const int h = (n - 1024) >> 8, d = n & 255; v2u w; w.x = cvtpk(v[0], v[1]); w.y = cvtpk(v[2], v[3]); *(v2u*)(VT + (((size_t)bb * 4 + h) * 256 + d) * 256 + key) = w; } } }
    }
}

__device__ __forceinline__ void ssd_passA(const Frame& F, const Args& a, const bf16* proj, bf16* Sst, float* cdec) {
    LAS unsigned char* TB = F.lds; LAS unsigned char* TX0 = F.lds + 32768;
    LAS float* WS = (LAS float*)(F.lds + 98304);
    const float* dtb = (const float*)(a.ws + WS_DT);
    const int lane = F.lane, wave = F.wave;
    for (int u = F.bid; u < 1024; u += F.G) {
        const int b = u >> 9, c = (u >> 2) & 127, hq = u & 3, g = hq >> 1;
        const size_t row0 = (size_t)b * SEQ + (size_t)c * 128;
        if (wave < 4) { const int hd = hq * 4 + wave; const float av = -__expf(a.in[7][hd]);
            const float dt0 = dtb[(row0 + 2 * lane) * 16 + hd], dt1 = dtb[(row0 + 2 * lane + 1) * 16 + hd];
            const float v0 = dt0 * av, v1 = dt1 * av; float incl = v0 + v1;
#pragma unroll
            for (int o = 1; o < 64; o <<= 1) { const float t = __shfl_up(incl, o); if (lane >= o) incl += t; }
            const float last = __shfl(incl, 63); const float ac1 = incl, ac0 = incl - v1;
            WS[wave * 128 + 2 * lane] = dt0 * __expf(last - ac0); WS[wave * 128 + 2 * lane + 1] = dt1 * __expf(last - ac1);
            if (lane == 63) cdec[((size_t)b * 128 + c) * 16 + hd] = __expf(last); }
        __syncthreads();
        { const int cx = F.tid & 31, rr = F.tid >> 5; LAS unsigned char* TX = TX0 + (cx >> 4) * 32768; const LAS float* wsr = WS + (cx >> 3) * 128;
          const int cb_ = F.tid & 15, rb = F.tid >> 4;
          ConvIn<8> cix; ConvIn<4> cib;
          conv_load<8>(cix, proj + row0 * PJ + C_X + hq * 256 + cx * 8, c * 128, rr * 8);
          conv_load<4>(cib, proj + row0 * PJ + C_B + g * 128 + cb_ * 8, c * 128, rb * 4);
          conv_apply<8>(cix, rr * 8, a.in[4], a.in[5], hq * 256 + cx * 8,
              [&](int r, const float (&o)[8]) { const float sc = wsr[r]; v4u w; w.x = cvtpk(o[0] * sc, o[1] * sc); w.y = cvtpk(o[2] * sc, o[3] * sc); w.z = cvtpk(o[4] * sc, o[5] * sc); w.w = cvtpk(o[6] * sc, o[7] * sc);
                  *(LAS v4u*)(TX + offb(r, cx & 15)) = w; });
          conv_apply<4>(cib, rb * 4, a.in[4], a.in[5], 1024 + g * 128 + cb_ * 8,
              [&](int r, const float (&o)[8]) { v4u w; w.x = cvtpk(o[0], o[1]); w.y = cvtpk(o[2], o[3]); w.z = cvtpk(o[4], o[5]); w.w = cvtpk(o[6], o[7]); *(LAS v4u*)(TB + offb(r, cb_)) = w; }); }
        __syncthreads();
        { const int hh = wave >> 1, nh = wave & 1; const LAS unsigned char* TX = TX0 + (hh >> 1) * 32768; const int cbase = (hh & 1) * 2;
          f32x16 acc[2][2];
#pragma unroll
          for (int i = 0; i < 2; ++i)
#pragma unroll
              for (int j = 0; j < 2; ++j)
#pragma unroll
                  for (int r = 0; r < 16; ++r) acc[i][j][r] = 0.f;
#pragma unroll 2
          for (int ks = 0; ks < 8; ++ks) { bf16x8 A[2], B[2];
#pragma unroll
              for (int i = 0; i < 2; ++i) { A[i] = frag_tr<false>(TX, cbase + i, ks, lane); B[i] = frag_tr<false>(TB, 2 * nh + i, ks, lane); }
#pragma unroll
              for (int i = 0; i < 2; ++i)
#pragma unroll
                  for (int j = 0; j < 2; ++j) acc[i][j] = MFMA32(A[i], B[j], acc[i][j]); }
          bf16* sp = Sst + (((size_t)b * 128 + c) * 16 + hq * 4 + hh) * 8192;
#pragma unroll
          for (int i = 0; i < 2; ++i)
#pragma unroll
              for (int j = 0; j < 2; ++j)
#pragma unroll
                  for (int r = 0; r < 16; r += 2) { const bool odd = lane & 1; const float snd = odd ? acc[i][j][r] : acc[i][j][r + 1]; const float rcv = __shfl_xor(snd, 1);
                      const int p = 32 * i + (r & 3) + 8 * (r >> 2) + 4 * (lane >> 5) + (odd ? 1 : 0), n = 64 * nh + 32 * j + (lane & 30);
                      *(unsigned*)(sp + p * 128 + n) = odd ? cvtpk(rcv, acc[i][j][r + 1]) : cvtpk(acc[i][j][r], rcv); } }
        __syncthreads();
    }
}
template <bool DRY = false> __device__ __forceinline__ void ssd_scan(const Frame& F, bf16* Sst, const float* cdec) {
    for (int gid = F.bid * (NWAVES * 64) + F.tid; gid < 131072; gid += F.G * NWAVES * 64) {
        const int b = gid >> 16, q = gid & 65535, h = q >> 12;
        unsigned* p = (unsigned*)(Sst + (size_t)b * 128 * 131072 + 2 * q); const float* dc = cdec + (size_t)b * 128 * 16 + h;
        float r0 = 0.f, r1 = 0.f;
        for (int c0 = 0; c0 < 128; c0 += 8) { unsigned v[8]; float d[8];
#pragma unroll
            for (int i = 0; i < 8; ++i) { v[i] = p[(size_t)(c0 + i) * 65536]; d[i] = dc[(c0 + i) * 16]; }
#pragma unroll
            for (int i = 0; i < 8; ++i) { if (!DRY || r0 == 123.456f) p[(size_t)(c0 + i) * 65536] = pk2(r0, r1); r0 = r0 * d[i] + bflo(v[i]); r1 = r1 * d[i] + bfhi(v[i]); } }
    }
}
__device__ __forceinline__ void ssd_passC(const Frame& F, const Args& a, bf16* proj, const bf16* Sst, float* ssqy, const bool DRY = false) {
    LAS unsigned char* TC = F.lds; LAS unsigned char* TB = F.lds + 32768; LAS unsigned char* ST = F.lds;
    LAS unsigned char* TX0 = F.lds + 67584;
    LAS float* ACU = (LAS float*)(F.lds + 133120); LAS float* DTS = ACU + 512;
    const float* dtb = (const float*)(a.ws + WS_DT);
    const int lane = F.lane, wave = F.wave, hl = lane >> 5;
    for (int u = F.bid; u < 1024; u += F.G) {
        const int b = u >> 9, c = (u >> 2) & 127, hq = u & 3, g = hq >> 1;
        const size_t row0 = (size_t)b * SEQ + (size_t)c * 128;
        if (wave < 4) { const int hd = hq * 4 + wave; const float av = -__expf(a.in[7][hd]);
            const float dt0 = dtb[(row0 + 2 * lane) * 16 + hd], dt1 = dtb[(row0 + 2 * lane + 1) * 16 + hd];
            const float v0 = dt0 * av, v1 = dt1 * av; float incl = v0 + v1;
#pragma unroll
            for (int o = 1; o < 64; o <<= 1) { const float t = __shfl_up(incl, o); if (lane >= o) incl += t; }
            ACU[wave * 128 + 2 * lane] = incl - v1; ACU[wave * 128 + 2 * lane + 1] = incl; DTS[wave * 128 + 2 * lane] = dt0; DTS[wave * 128 + 2 * lane + 1] = dt1; }
        { const int cx = F.tid & 31, rr = F.tid >> 5; LAS unsigned char* TX = TX0 + (cx >> 4) * 32768;
          LAS unsigned char* TT = (cx < 16) ? TB : TC; const int cc = cx & 15; const int scol = (cx < 16 ? C_B : C_C) + g * 128 + cc * 8; const int cch = (cx < 16 ? 1024 : 1280) + g * 128 + cc * 8;
          ConvIn<8> cix, cib;
          conv_load<8>(cix, proj + row0 * PJ + C_X + hq * 256 + cx * 8, c * 128, rr * 8);
          conv_apply<8>(cix, rr * 8, a.in[4], a.in[5], hq * 256 + cx * 8,
              [&](int r, const float (&o)[8]) { v4u w; w.x = cvtpk(o[0], o[1]); w.y = cvtpk(o[2], o[3]); w.z = cvtpk(o[4], o[5]); w.w = cvtpk(o[6], o[7]); *(LAS v4u*)(TX + offb(r, cx & 15)) = w; });
          conv_load<8>(cib, proj + row0 * PJ + scol, c * 128, rr * 8);
          conv_apply<8>(cib, rr * 8, a.in[4], a.in[5], cch,
              [&](int r, const float (&o)[8]) { v4u w; w.x = cvtpk(o[0], o[1]); w.y = cvtpk(o[2], o[3]); w.z = cvtpk(o[4], o[5]); w.w = cvtpk(o[6], o[7]); *(LAS v4u*)(TT + offb(r, cc)) = w; }); }
        __syncthreads();
        const int lb = wave & 3, hh2 = wave >> 2; const int l = 32 * lb + (lane & 31);
        f32x16 Y[2][2];
        {
            const LAS unsigned char* TX = TX0 + hh2 * 32768;
#pragma unroll
            for (int e = 0; e < 2; ++e)
#pragma unroll
                for (int pb = 0; pb < 2; ++pb)
#pragma unroll
                    for (int r = 0; r < 16; ++r) Y[e][pb][r] = 0.f;
            const bf16* sp = Sst + (((size_t)b * 128 + c) * 16 + hq * 4 + 2 * hh2) * 8192 + (size_t)(lane & 31) * 128 + 8 * hl;
#pragma unroll 1
            for (int kq = 0; kq < 2; ++kq) { bf16x8 sf[4][2][2];
#pragma unroll
                for (int k4 = 0; k4 < 4; ++k4)
#pragma unroll
                    for (int e = 0; e < 2; ++e) { sf[k4][e][0] = *(const bf16x8*)(sp + e * 8192 + 16 * (4 * kq + k4)); sf[k4][e][1] = *(const bf16x8*)(sp + e * 8192 + 32 * 128 + 16 * (4 * kq + k4)); }
#pragma unroll
                for (int k4 = 0; k4 < 4; ++k4) { const bf16x8 cf = frag_row(TC, lb, 4 * kq + k4, lane);
#pragma unroll
                    for (int e = 0; e < 2; ++e) { Y[e][0] = MFMA32(sf[k4][e][0], cf, Y[e][0]); Y[e][1] = MFMA32(sf[k4][e][1], cf, Y[e][1]); } } }
            float al[2];
#pragma unroll
            for (int e = 0; e < 2; ++e) { al[e] = ACU[(2 * hh2 + e) * 128 + l]; const float el = __expf(al[e]);
#pragma unroll
                for (int pb = 0; pb < 2; ++pb)
#pragma unroll
                    for (int r = 0; r < 16; ++r) Y[e][pb][r] *= el; }
#pragma unroll 1
            for (int sb = 0; sb <= lb; ++sb) {
                f32x16 GT;
#pragma unroll
                for (int r = 0; r < 16; ++r) GT[r] = 0.f;
#pragma unroll 2
                for (int ks = 0; ks < 8; ++ks) GT = MFMA32(frag_row(TB, sb, ks, lane), frag_row(TC, lb, ks, lane), GT);
#pragma unroll
                for (int s2 = 0; s2 < 2; ++s2)
#pragma unroll
                    for (int e = 0; e < 2; ++e) { const int hloc = 2 * hh2 + e; float v[8];
#pragma unroll
                        for (int j = 0; j < 8; ++j) { const int reg = 8 * s2 + j; const int s = 32 * sb + (reg & 3) + 8 * (reg >> 2) + 4 * hl;
                            const float as = ACU[hloc * 128 + s], ds = DTS[hloc * 128 + s];
                            v[j] = (s <= l) ? GT[reg] * __expf(fminf(al[e] - as, 0.f)) * ds : 0.f; }
                        v4u w; w.x = cvtpk(v[0], v[1]); w.y = cvtpk(v[2], v[3]); w.z = cvtpk(v[4], v[5]); w.w = cvtpk(v[6], v[7]);
                        const bf16x8 bfr = __builtin_bit_cast(bf16x8, w);
                        Y[e][0] = MFMA32(frag_tr<true>(TX, 2 * e + 0, 2 * sb + s2, lane), bfr, Y[e][0]);
                        Y[e][1] = MFMA32(frag_tr<true>(TX, 2 * e + 1, 2 * sb + s2, lane), bfr, Y[e][1]); }
            }
        }
        __syncthreads();
#pragma unroll
        for (int e = 0; e < 2; ++e)
#pragma unroll
            for (int pb = 0; pb < 2; ++pb)
#pragma unroll
                for (int q = 0; q < 4; ++q) { const int chl = (2 * hh2 + e) * 64 + 32 * pb + 8 * q + 4 * hl; v2u w; w.x = cvtpk(Y[e][pb][4 * q], Y[e][pb][4 * q + 1]); w.y = cvtpk(Y[e][pb][4 * q + 2], Y[e][pb][4 * q + 3]); *(LAS v2u*)(ST + l * 528 + chl * 2) = w; }
        __syncthreads();
        { const int cx = F.tid & 31, rq = F.tid >> 5; const float Dh = a.in[8][hq * 4 + (cx >> 3)]; const LAS unsigned char* TX = TX0 + (cx >> 4) * 32768;
          v4u zr[8];
#pragma unroll
          for (int i = 0; i < 8; ++i) zr[i] = *(const v4u*)(proj + (row0 + rq + 16 * i) * PJ + C_Z + hq * 256 + cx * 8);
#pragma unroll
          for (int i = 0; i < 8; ++i) { const int r = rq + 16 * i; float y[8], x[8], z[8];
              unpack8(*(const LAS v4u*)(ST + r * 528 + cx * 16), y); unpack8(*(const LAS v4u*)(TX + offb(r, cx & 15)), x);
              bf16* zp = proj + (row0 + r) * PJ + C_Z + hq * 256 + cx * 8; unpack8(zr[i], z);
              float o[8]; float ss = 0.f;
#pragma unroll
              for (int e = 0; e < 8; ++e) { o[e] = (y[e] + Dh * x[e]) * z[e]; ss += o[e] * o[e]; }
              v4u w; w.x = cvtpk(o[0], o[1]); w.y = cvtpk(o[2], o[3]); w.z = cvtpk(o[4], o[5]); w.w = cvtpk(o[6], o[7]); if (!DRY || ss == -1.f) *(v4u*)zp = w;
#pragma unroll
              for (int o2 = 1; o2 < 32; o2 <<= 1) ss += __shfl_xor(ss, o2);
              if (cx == 0 && (!DRY || ss == -1.f)) atomicAdd(ssqy + (row0 + r) * 2 + g, ss); } }
        __syncthreads();
    }
}
__device__ __forceinline__ void s_norms2(const Frame& F, bf16* proj, const float* ssqy) {
    const int gw = F.bid * NWAVES + F.wave, NGW = F.G * NWAVES;
    for (int m = gw; m < T; m += NGW) {
        bf16* pr = proj + (size_t)m * PJ;
#pragma unroll
        for (int g = 0; g < 2; ++g) { float x[8]; unpack8(*(const v4u*)(pr + C_Z + g * 512 + 8 * F.lane), x);
            const float r = 1.0f / sqrtf(ssqy[(size_t)m * 2 + g] * (1.f / 512.f) + EPS);
            v4u o; o.x = pk2(x[0] * r, x[1] * r); o.y = pk2(x[2] * r, x[3] * r); o.z = pk2(x[4] * r, x[5] * r); o.w = pk2(x[6] * r, x[7] * r);
            *(v4u*)(pr + C_Z + g * 512 + 8 * F.lane) = o; }
#pragma unroll
        for (int h = 0; h < 8; ++h) { const unsigned w = *(const unsigned*)(pr + C_Q + h * 128 + 2 * F.lane); const unsigned gt = *(const unsigned*)(pr + C_G + h * 128 + 2 * F.lane);
            const float o0 = bflo(w), o1 = bfhi(w);
            const float r = 1.0f / sqrtf(wave_sum(o0 * o0 + o1 * o1) * (1.f / 128.f) + EPS);
            *(unsigned*)(pr + C_G + h * 128 + 2 * F.lane) = pk2(o0 * r * siluf_(bflo(gt)), o1 * r * siluf_(bfhi(gt))); }
    }
}


struct HgGate { float bc[8][2], kk[8][2], tot[2], ref[2]; };
__device__ __forceinline__ void hg_gates(const Frame& F, const unsigned (&hfw)[8], LAS float* SEG, HgGate& G) {
    const int kp = F.tid & 63, seg = F.tid >> 6, k0 = 2 * kp;
    float c0 = 0.f, c1 = 0.f;
#pragma unroll
    for (int i = 0; i < 8; ++i) { const float g0 = bflo(hfw[i]), g1 = bfhi(hfw[i]);
        c0 += g0; c1 += g1; G.bc[i][0] = c0; G.bc[i][1] = c1; G.kk[i][0] = 1.f - __builtin_amdgcn_exp2f(g0); G.kk[i][1] = 1.f - __builtin_amdgcn_exp2f(g1); }
    *(LAS f32x2*)(SEG + seg * 128 + k0) = (f32x2){c0, c1};
    __syncthreads();
    float o0 = 0.f, o1 = 0.f, t0 = 0.f, t1 = 0.f, r0 = 0.f, r1 = 0.f;
#pragma unroll
    for (int s2 = 0; s2 < 8; ++s2) { const f32x2 v = *(const LAS f32x2*)(SEG + s2 * 128 + k0); if (s2 < seg) { o0 += v.x; o1 += v.y; } if (s2 < 4) { r0 += v.x; r1 += v.y; } t0 += v.x; t1 += v.y; }
#pragma unroll
    for (int i = 0; i < 8; ++i) { G.bc[i][0] += o0; G.bc[i][1] += o1; }
    G.tot[0] = t0; G.tot[1] = t1; G.ref[0] = r0; G.ref[1] = r1;
}
__device__ __forceinline__ void hg_passA(const Frame& F, const Args& a, const bf16* proj, bf16* Hst, float* hdec) {
    LAS unsigned char* KD = F.lds; LAS unsigned char* TV = F.lds + 16384; LAS float* SEG = (LAS float*)(F.lds + 32768);
    const int lane = F.lane, wave = F.wave;
    for (int u = F.bid; u < 4096; u += F.G) {
        const int b = u >> 11, c = (u >> 3) & 255, h = u & 7; const size_t row0 = (size_t)b * SEQ + (size_t)c * 64;
        unsigned hfw[8]; v4u vv[2];
#pragma unroll
        for (int i = 0; i < 8; ++i) hfw[i] = *(const unsigned*)(proj + (row0 + (F.tid >> 6) * 8 + i) * PJ + C_F + h * 128 + 2 * (F.tid & 63));
#pragma unroll
        for (int i = 0; i < 2; ++i) { const int idx = F.tid + 512 * i, r = idx >> 4, ch = idx & 15; vv[i] = *(const v4u*)(proj + (row0 + r) * PJ + C_I + h * 128 + ch * 8); }
        HgGate G; hg_gates(F, hfw, SEG, G);
        { const int kp = F.tid & 63, seg = F.tid >> 6, k0 = 2 * kp;
#pragma unroll
          for (int i = 0; i < 8; ++i) { const int j = seg * 8 + i; const float d0 = G.kk[i][0] * __builtin_amdgcn_exp2f(G.tot[0] - G.bc[i][0]), d1 = G.kk[i][1] * __builtin_amdgcn_exp2f(G.tot[1] - G.bc[i][1]);
              *(LAS unsigned*)(KD + offb(j, k0 >> 3) + (k0 & 7) * 2) = cvtpk(d0, d1); }
          if (seg == 0) *(f32x2*)(hdec + (((size_t)b * 256 + c) * 8 + h) * 128 + k0) = (f32x2){__builtin_amdgcn_exp2f(G.tot[0]), __builtin_amdgcn_exp2f(G.tot[1])}; }
#pragma unroll
        for (int i = 0; i < 2; ++i) { const int idx = F.tid + 512 * i, r = idx >> 4, ch = idx & 15; *(LAS v4u*)(TV + offb(r, ch)) = vv[i]; }
        __syncthreads();
        { const int vb = wave >> 1, kb0 = 2 * (wave & 1);
          f32x16 acc[2];
#pragma unroll
          for (int j = 0; j < 2; ++j)
#pragma unroll
              for (int r = 0; r < 16; ++r) acc[j][r] = 0.f;
#pragma unroll
          for (int ks = 0; ks < 4; ++ks) { const bf16x8 A = frag_tr<false>(TV, vb, ks, lane);
#pragma unroll
              for (int j = 0; j < 2; ++j) acc[j] = MFMA32(A, frag_tr<false>(KD, kb0 + j, ks, lane), acc[j]); }
          bf16* sp = Hst + (((size_t)b * 256 + c) * 8 + h) * 16384;
#pragma unroll
          for (int j = 0; j < 2; ++j)
#pragma unroll
              for (int r = 0; r < 16; r += 2) { const bool odd = lane & 1; const float snd = odd ? acc[j][r] : acc[j][r + 1]; const float rcv = __shfl_xor(snd, 1);
                  const int v = 32 * vb + (r & 3) + 8 * (r >> 2) + 4 * (lane >> 5) + (odd ? 1 : 0), k = 32 * (kb0 + j) + (lane & 30);
                  *(unsigned*)(sp + v * 128 + k) = odd ? cvtpk(rcv, acc[j][r + 1]) : cvtpk(acc[j][r], rcv); } }
        __syncthreads();
    }
}
template <bool DRY = false> __device__ __forceinline__ void hg_scan(const Frame& F, bf16* Hst, const float* hdec) {
    for (int gid = F.bid * (NWAVES * 64) + F.tid; gid < 131072; gid += F.G * NWAVES * 64) {
        const int b = gid >> 16, q = gid & 65535, h = q >> 13, k0 = (2 * q) & 127;
        unsigned* p = (unsigned*)(Hst + (size_t)b * 256 * 131072 + 2 * q); const float* dc = hdec + ((size_t)b * 256 * 8 + h) * 128 + k0;
        float r0 = 0.f, r1 = 0.f;
        for (int c0 = 0; c0 < 256; c0 += 8) { unsigned v[8]; f32x2 d[8];
#pragma unroll
            for (int i = 0; i < 8; ++i) { v[i] = p[(size_t)(c0 + i) * 65536]; d[i] = *(const f32x2*)(dc + (size_t)(c0 + i) * 1024); }
#pragma unroll
            for (int i = 0; i < 8; ++i) { if (!DRY || r0 == 123.456f) p[(size_t)(c0 + i) * 65536] = pk2(r0, r1); r0 = r0 * d[i].x + bflo(v[i]); r1 = r1 * d[i].y + bfhi(v[i]); } }
    }
}
__device__ __forceinline__ void hg_passC(const Frame& F, const Args& a, bf16* proj, const bf16* Hst, const bool DRY = false) {
    LAS unsigned char* QE = F.lds; LAS unsigned char* KE = F.lds + 16384; LAS unsigned char* QS = F.lds + 32768; LAS unsigned char* TV = F.lds + 49152; LAS unsigned char* SIN = F.lds + 65536;
    LAS float* SEG = (LAS float*)(F.lds + 98304); LAS unsigned char* OST = F.lds + 102400;
    const int lane = F.lane, wave = F.wave, hl = lane >> 5;
    for (int u = F.bid; u < 4096; u += F.G) {
        const int b = u >> 11, c = (u >> 3) & 255, h = u & 7; const size_t row0 = (size_t)b * SEQ + (size_t)c * 64;
        unsigned hfw[8], hqw[8]; v4u vv[2], sv[4], gg[2];
#pragma unroll
        for (int i = 0; i < 8; ++i) { hfw[i] = *(const unsigned*)(proj + (row0 + (F.tid >> 6) * 8 + i) * PJ + C_F + h * 128 + 2 * (F.tid & 63)); hqw[i] = *(const unsigned*)(proj + (row0 + (F.tid >> 6) * 8 + i) * PJ + C_Q + h * 128 + 2 * (F.tid & 63)); }
#pragma unroll
        for (int i = 0; i < 2; ++i) { const int idx = F.tid + 512 * i, r = idx >> 4, ch = idx & 15; vv[i] = *(const v4u*)(proj + (row0 + r) * PJ + C_I + h * 128 + ch * 8); }
        { const bf16* sp = Hst + (((size_t)b * 256 + c) * 8 + h) * 16384;
#pragma unroll
          for (int i = 0; i < 4; ++i) { const int idx = F.tid + 512 * i, r = idx >> 4, ch = idx & 15; sv[i] = *(const v4u*)(sp + r * 128 + ch * 8); } }
        bf16* gp = proj + (row0 + (F.tid >> 3)) * PJ + C_G + h * 128 + (F.tid & 7) * 16;
        gg[0] = *(const v4u*)gp; gg[1] = *(const v4u*)(gp + 8);
        HgGate G; hg_gates(F, hfw, SEG, G);
        { const int kp = F.tid & 63, seg = F.tid >> 6, k0 = 2 * kp;
#pragma unroll
          for (int i = 0; i < 8; ++i) { const int j = seg * 8 + i; const unsigned w = hqw[i];
              const float q0 = bflo(w), q1 = bfhi(w); const unsigned o = offb(j, k0 >> 3) + (k0 & 7) * 2;
              *(LAS unsigned*)(QE + o) = cvtpk(q0 * __builtin_amdgcn_exp2f(G.bc[i][0] - G.ref[0]), q1 * __builtin_amdgcn_exp2f(G.bc[i][1] - G.ref[1]));
              *(LAS unsigned*)(KE + o) = cvtpk(G.kk[i][0] * __builtin_amdgcn_exp2f(G.ref[0] - G.bc[i][0]), G.kk[i][1] * __builtin_amdgcn_exp2f(G.ref[1] - G.bc[i][1]));
              *(LAS unsigned*)(QS + o) = cvtpk(q0 * __builtin_amdgcn_exp2f(G.bc[i][0]), q1 * __builtin_amdgcn_exp2f(G.bc[i][1])); } }
#pragma unroll
        for (int i = 0; i < 2; ++i) { const int idx = F.tid + 512 * i, r = idx >> 4, ch = idx & 15; *(LAS v4u*)(TV + offb(r, ch)) = vv[i]; }
#pragma unroll
        for (int i = 0; i < 4; ++i) { const int idx = F.tid + 512 * i, r = idx >> 4, ch = idx & 15; *(LAS v4u*)(SIN + offb(r, ch)) = sv[i]; }
        __syncthreads();
        { const int vb = wave & 3, ib = wave >> 2; const int it = 32 * ib + (lane & 31);
          f32x16 acc;
#pragma unroll
          for (int r = 0; r < 16; ++r) acc[r] = 0.f;
#pragma unroll 2
          for (int ks = 0; ks < 8; ++ks) acc = MFMA32(frag_row(SIN, vb, ks, lane), frag_row(QS, ib, ks, lane), acc);
#pragma unroll 1
          for (int jb = 0; jb <= ib; ++jb) { f32x16 AT;
#pragma unroll
              for (int r = 0; r < 16; ++r) AT[r] = 0.f;
#pragma unroll 2
              for (int ks = 0; ks < 8; ++ks) AT = MFMA32(frag_row(KE, jb, ks, lane), frag_row(QE, ib, ks, lane), AT);
#pragma unroll
              for (int s2 = 0; s2 < 2; ++s2) { float v[8];
#pragma unroll
                  for (int j = 0; j < 8; ++j) { const int reg = 8 * s2 + j; const int jt = 32 * jb + (reg & 3) + 8 * (reg >> 2) + 4 * hl; v[j] = (jt <= it) ? AT[reg] : 0.f; }
                  v4u w; w.x = cvtpk(v[0], v[1]); w.y = cvtpk(v[2], v[3]); w.z = cvtpk(v[4], v[5]); w.w = cvtpk(v[6], v[7]);
                  acc = MFMA32(frag_tr<true>(TV, vb, 2 * jb + s2, lane), __builtin_bit_cast(bf16x8, w), acc); } }
#pragma unroll
          for (int q = 0; q < 4; ++q) *(LAS f32x4*)(OST + it * 528 + (32 * vb + 8 * q + 4 * hl) * 4) = (f32x4){acc[4 * q], acc[4 * q + 1], acc[4 * q + 2], acc[4 * q + 3]}; }
        __syncthreads();
        { const int i = F.tid >> 3, vg = F.tid & 7; float o[16]; float ss = 0.f;
#pragma unroll
          for (int q = 0; q < 4; ++q) { const f32x4 t = *(const LAS f32x4*)(OST + i * 528 + (vg * 16 + 4 * q) * 4); o[4 * q] = t.x; o[4 * q + 1] = t.y; o[4 * q + 2] = t.z; o[4 * q + 3] = t.w; ss += (t.x * t.x + t.y * t.y) + (t.z * t.z + t.w * t.w); }
          ss += __shfl_xor(ss, 1); ss += __shfl_xor(ss, 2); ss += __shfl_xor(ss, 4);
          const float rs = __builtin_amdgcn_rsqf(ss * (1.f / 128.f) + EPS);
#pragma unroll
          for (int hf = 0; hf < 2; ++hf) { float gt[8]; unpack8(gg[hf], gt); v4u w;
              w.x = cvtpk(o[8 * hf + 0] * rs * gt[0], o[8 * hf + 1] * rs * gt[1]); w.y = cvtpk(o[8 * hf + 2] * rs * gt[2], o[8 * hf + 3] * rs * gt[3]);
              w.z = cvtpk(o[8 * hf + 4] * rs * gt[4], o[8 * hf + 5] * rs * gt[5]); w.w = cvtpk(o[8 * hf + 6] * rs * gt[6], o[8 * hf + 7] * rs * gt[7]);
              if (!DRY || ss == -1.f) *(v4u*)(gp + 8 * hf) = w; } }
        __syncthreads();
    }
}
template <bool DRY = false> __device__ __forceinline__ void ssd_norm(const Frame& F, bf16* proj, const float* ssqy) {
    const int gw = F.bid * NWAVES + F.wave, NGW = F.G * NWAVES;
    for (int m = gw; m < T; m += NGW) {
        bf16* pr = proj + (size_t)m * PJ;
#pragma unroll
        for (int g = 0; g < 2; ++g) { float x[8]; unpack8(*(const v4u*)(pr + C_Z + g * 512 + 8 * F.lane), x);
            const float r = 1.0f / sqrtf(ssqy[(size_t)m * 2 + g] * (1.f / 512.f) + EPS);
            v4u o; o.x = cvtpk(x[0] * r, x[1] * r); o.y = cvtpk(x[2] * r, x[3] * r); o.z = cvtpk(x[4] * r, x[5] * r); o.w = cvtpk(x[6] * r, x[7] * r);
            if (!DRY || r == -1.f) *(v4u*)(pr + C_Z + g * 512 + 8 * F.lane) = o; }
    }
}


__device__ __forceinline__ void load_256sq(const Frame& F, LAS unsigned char* dst, const bf16* src) {
#pragma unroll 4
    for (int i = 0; i < 16; ++i) { const int idx = F.tid + 512 * i, r = idx >> 5, c16 = idx & 31; *(LAS v4u*)(dst + (c16 >> 4) * 65536 + offb(r, c16 & 15)) = *(const v4u*)(src + r * 256 + c16 * 8); }
}
__device__ __forceinline__ bf16x8 frag_row_perm(const LAS unsigned char* tile, int rb, int ks, int lane) {
    const int row = rb * 32 + (lane & 31), h = lane >> 5;
    const v2u a = *(const LAS v2u*)(tile + offb(row, 2 * ks) + 8 * h), b = *(const LAS v2u*)(tile + offb(row, 2 * ks + 1) + 8 * h);
    return __builtin_bit_cast(bf16x8, ((v4u){a.x, a.y, b.x, b.y}));
}
__device__ __forceinline__ void attn_phase(const Frame& F, const Args& a, bf16* proj) {
    const bf16* KM = (const bf16*)(a.ws + WS_KM); const bf16* VT = (const bf16*)(a.ws + WS_VT);
    LAS unsigned char* KV = F.lds;
    const int lane = F.lane, wave = F.wave, hl = lane >> 5;
    for (int u = F.bid; u < 512; u += F.G) {
        const int head = u >> 7, tile = u & 127, b = tile >> 6;
        const size_t rowq = (size_t)tile * 256 + wave * 32 + (lane & 31);
        const bf16* qp = proj + rowq * PJ + C_QA + head * 256 + 8 * hl;
        load_256sq(F, KV, KM + ((size_t)b * 4 + head) * 65536);
        __syncthreads();
        float mh[2], sh[2]; v4u P[8][2];
#pragma unroll
        for (int half = 0; half < 2; ++half) {
            f32x16 S[4];
#pragma unroll
            for (int kb = 0; kb < 4; ++kb)
#pragma unroll
                for (int r = 0; r < 16; ++r) S[kb][r] = 0.f;
#pragma unroll 1
            for (int kc = 0; kc < 4; ++kc) { bf16x8 qf[4];
#pragma unroll
                for (int ks = 0; ks < 4; ++ks) qf[ks] = *(const bf16x8*)(qp + kc * 64 + 16 * ks);
#pragma unroll
                for (int kb = 0; kb < 4; ++kb)
#pragma unroll
                    for (int ks = 0; ks < 4; ++ks) S[kb] = MFMA32(frag_row(KV + (kc >> 1) * 65536, half * 4 + kb, (kc & 1) * 4 + ks, lane), qf[ks], S[kb]); }
            float mx = -3.0e38f;
#pragma unroll
            for (int kb = 0; kb < 4; ++kb)
#pragma unroll
                for (int r = 0; r < 16; ++r) mx = fmaxf(mx, S[kb][r]);
            mx = fmaxf(mx, __shfl_xor(mx, 32));
            float sum = 0.f;
#pragma unroll
            for (int kb = 0; kb < 4; ++kb) {
#pragma unroll
                for (int r = 0; r < 16; ++r) { S[kb][r] = __expf(S[kb][r] - mx); sum += S[kb][r]; }
#pragma unroll
                for (int s2 = 0; s2 < 2; ++s2) { v4u w; w.x = cvtpk(S[kb][8 * s2], S[kb][8 * s2 + 1]); w.y = cvtpk(S[kb][8 * s2 + 2], S[kb][8 * s2 + 3]); w.z = cvtpk(S[kb][8 * s2 + 4], S[kb][8 * s2 + 5]); w.w = cvtpk(S[kb][8 * s2 + 6], S[kb][8 * s2 + 7]); P[half * 4 + kb][s2] = w; } }
            sum += __shfl_xor(sum, 32);
            mh[half] = mx; sh[half] = sum;
        }
        const float mt = fmaxf(mh[0], mh[1]); float c0 = __expf(mh[0] - mt), c1 = __expf(mh[1] - mt);
        { const float inv = 1.0f / (c0 * sh[0] + c1 * sh[1]); c0 *= inv; c1 *= inv; }
        __syncthreads();
        load_256sq(F, KV, VT + ((size_t)b * 4 + head) * 65536);
        __syncthreads();
        bf16* op = proj + rowq * PJ + C_OX + head * 256 + 4 * hl;
#pragma unroll 1
        for (int db = 0; db < 8; ++db) { f32x16 o0, o1;
#pragma unroll
            for (int r = 0; r < 16; ++r) { o0[r] = 0.f; o1[r] = 0.f; }
#pragma unroll
            for (int kb = 0; kb < 4; ++kb)
#pragma unroll
                for (int s2 = 0; s2 < 2; ++s2) { o0 = MFMA32(frag_row_perm(KV, db, kb * 2 + s2, lane), __builtin_bit_cast(bf16x8, P[kb][s2]), o0);
                    o1 = MFMA32(frag_row_perm(KV + 65536, db, kb * 2 + s2, lane), __builtin_bit_cast(bf16x8, P[4 + kb][s2]), o1);
                    if (s2 == 1 && (kb & 1)) __builtin_amdgcn_sched_barrier(0); }
#pragma unroll
            for (int q = 0; q < 4; ++q) { v2u w; w.x = cvtpk(o0[4 * q] * c0 + o1[4 * q] * c1, o0[4 * q + 1] * c0 + o1[4 * q + 1] * c1); w.y = cvtpk(o0[4 * q + 2] * c0 + o1[4 * q + 2] * c1, o0[4 * q + 3] * c0 + o1[4 * q + 3] * c1); *(v2u*)(op + 32 * db + 8 * q) = w; } }
        __syncthreads();
    }
}

#ifndef REP_P0
#define REP_P0 1
#endif
#ifndef REP_A
#define REP_A 1
#endif
#ifndef REP_C
#define REP_C 1
#endif
#ifndef REP_ATT
#define REP_ATT 1
#endif
#ifndef REP_AS
#define REP_AS 1
#endif
#ifndef REP_AH
#define REP_AH 1
#endif
#ifndef REP_CS
#define REP_CS 1
#endif
#ifndef REP_CH
#define REP_CH 1
#endif
#ifndef REP_G1
#define REP_G1 1
#endif
#ifndef REP_G9
#define REP_G9 1
#endif
__global__ void __launch_bounds__(NWAVES * 64, 2) hybrid_fwd(Args args) {
    extern __shared__ __attribute__((aligned(16))) unsigned char lds[];
    Frame F;
    F.lds = (LAS unsigned char*)lds;
    F.tid = threadIdx.x; F.lane = F.tid & 63; F.wave = __builtin_amdgcn_readfirstlane(F.tid >> 6);
    F.G = gridDim.x; F.bid = blockIdx.x;
    unsigned char* ws = args.ws;
    unsigned* ctl = (unsigned*)(ws + WS_CTL);
    for (int u = F.tid; u < (LDS_BYTES - LDSCTL_OFF) / 4; u += NWAVES * 64) ((LAS unsigned*)(F.lds + LDSCTL_OFF))[u] = 0u;
    __syncthreads();
    XcdBarrier bar = xcd_barrier_post(ctl + CW_BAR, (volatile LAS unsigned*)(F.lds + MISC_OFF) + 8);
#if defined(PROBE_K1)
    unsigned long long* tsb = (unsigned long long*)(ctl + 1024);
#define STAMP(i) do { if (F.bid == 0 && F.tid == 0) tsb[i] = __builtin_amdgcn_s_memrealtime(); } while (0)
#else
#define STAMP(i) do { } while (0)
#endif
#define NEWF() do { int t_ = threadIdx.x; asm volatile("" : "+v"(t_)); F.tid = t_; F.lane = t_ & 63; F.wave = __builtin_amdgcn_readfirstlane(t_ >> 6); } while (0)
#define GRID_BAR(i) do { xcd_barrier(bar); STAMP(i); NEWF(); } while (0)
    STAMP(0);
    bf16* proj = (bf16*)(ws + WS_PROJ);
    float* ssq1 = (float*)(ctl + CW_SSQ1); float* ssq2 = (float*)(ctl + CW_SSQ2); float* ssq3 = (float*)(ctl + CW_SSQ3);

    for (int rep = 0; rep < REP_P0; ++rep) { __syncthreads(); p0_prologue(F, args); NEWF(); p0_kv(F, args); NEWF(); }
    GRID_BAR(1);
    { pg8::Gemm g{(const bf16*)args.out, D, (const bf16*)(ws + WS_WIN), T, PJ, D}; pg8::StaticOrder S; S.init(T, PJ, F.G, F.bid);
      pg8::EpiProj E{proj, PJ, (const float*)(ws + WS_RSTD0), args.in[10]};
      for (int rep = 0; rep < REP_G1; ++rep) pg8::gemm_phase<pg8::EpiProj, pg8::StaticOrder, true, true>(F.lds + RING_OFF, g, S, E); }
    GRID_BAR(2);
    float* ssqy = (float*)(ctl + CW_SSQY); float* cdec = (float*)(ws + WS_CDEC); float* hdec = (float*)(ws + WS_HDEC); bf16* Sst = (bf16*)(ws + WS_SST); bf16* Hst = (bf16*)args.out;
    for (int rep = 0; rep < REP_A; ++rep) { for (int r2 = 0; r2 < REP_AS; ++r2) { ssd_passA(F, args, proj, Sst, cdec); NEWF(); } for (int r2 = 0; r2 < REP_AH; ++r2) { hg_passA(F, args, proj, Hst, hdec); NEWF(); } }
    GRID_BAR(3);
    ssd_scan(F, Sst, cdec);
    NEWF();
    hg_scan(F, Hst, hdec);
    GRID_BAR(4);
    for (int rep = 0; rep < REP_C; ++rep) { const bool dry = rep + 1 < REP_C; for (int r2 = 0; r2 < REP_CS; ++r2) { ssd_passC(F, args, proj, Sst, ssqy, dry || r2 + 1 < REP_CS); NEWF(); } for (int r2 = 0; r2 < REP_CH; ++r2) { hg_passC(F, args, proj, Hst, dry || r2 + 1 < REP_CH); NEWF(); } }
    GRID_BAR(5);
    ssd_norm(F, proj, ssqy);
    GRID_BAR(6);
    { pg8::Gemm g{proj + C_Z, PJ, (const bf16*)(ws + WS_WOUT), T, D, 2048}; pg8::StaticOrder S; S.init(T, D, F.G, F.bid);
      pg8::EpiRes E{args.in[0], args.out, proj + C_X1B, PJ, ssq1};
      pg8::gemm_phase<pg8::EpiRes, pg8::StaticOrder, true, true>(F.lds + RING_OFF, g, S, E); }
    GRID_BAR(7);
    { pg8::Gemm g{proj + C_X1B, PJ, (const bf16*)(ws + WS_WQ), T, D, D}; pg8::StaticOrder S; S.init(T, D, F.G, F.bid);
      pg8::EpiScaleBf16<1> E{proj + C_QA, PJ, ssq1};
      pg8::gemm_phase<pg8::EpiScaleBf16<1>, pg8::StaticOrder, true, true>(F.lds + RING_OFF, g, S, E); }
    GRID_BAR(8);
    for (int rep = 0; rep < REP_ATT; ++rep) attn_phase(F, args, proj);
    GRID_BAR(9);
    { pg8::Gemm g{proj + C_OX, PJ, (const bf16*)(ws + WS_WO), T, D, D}; pg8::StaticOrder S; S.init(T, D, F.G, F.bid);
      pg8::EpiRes E{args.out, args.out, proj + C_X2B, PJ, ssq2};
      pg8::gemm_phase<pg8::EpiRes, pg8::StaticOrder, true, true>(F.lds + RING_OFF, g, S, E); }
    GRID_BAR(10);
    { pg8::Gemm g{proj + C_X2B, PJ, (const bf16*)(ws + WS_WGU), T, 2 * FF, D}; pg8::StaticOrder S; S.init(T, 2 * FF, F.G, F.bid);
      pg8::EpiSwiglu E{proj + C_ACT, PJ, ssq2};
      for (int rep = 0; rep < REP_G9; ++rep) pg8::gemm_phase<pg8::EpiSwiglu, pg8::StaticOrder, true, true>(F.lds + RING_OFF, g, S, E); }
    GRID_BAR(11);
    { pg8::Gemm g{proj + C_ACT, PJ, (const bf16*)(ws + WS_WD), T, D, FF}; pg8::StaticOrder S; S.init(T, D, F.G, F.bid);
      pg8::EpiRes E{args.out, args.out, proj + C_X2B, PJ, ssq3};
      pg8::gemm_phase<pg8::EpiRes, pg8::StaticOrder, true, true>(F.lds + RING_OFF, g, S, E); }
    GRID_BAR(12);
    s_final(F, args, ssq3);
#if defined(PROBE_K1)
    { const unsigned long long* ts = (const unsigned long long*)(ctl + 1024);
      const float d1 = (float)(ts[PROBE_K1] - ts[PROBE_K1 - 1]) * 0.01f, d2 = (float)(ts[PROBE_K2] - ts[PROBE_K2 - 1]) * 0.01f;
      const float sc = 1.0f + d1 * (1.0f / 4000.0f);
      __syncthreads();
      const int gw = F.bid * NWAVES + F.wave, NGW = F.G * NWAVES;
      for (int m = gw; m < T; m += NGW) { f32x4* xr = (f32x4*)(args.out + (size_t)m * D) + F.lane;
#pragma unroll
          for (int j = 0; j < 4; ++j) { f32x4 v = xr[64 * j]; v = v * sc; if (m == 0 && j == 0 && F.lane == 0) v.x = d2; xr[64 * j] = v; } } }
#endif
}

extern "C" void kernel_launch(void* const* d_in, const int* in_sizes, int n_in, void* d_out, int out_size, void* d_ws, size_t ws_size, hipStream_t stream) {
    static int grid = 0;
    if (grid == 0) {
        if (n_in != 23 || in_sizes[0] != T * D || out_size != T * D || ws_size < WS_END) { fprintf(stderr, "kernel_launch: unexpected shapes / workspace (n_in %d, ws %zu, need %zu)\n", n_in, ws_size, (size_t)WS_END); grid = -1; return; }
        int dev = 0, cus = 0, per_cu = 0;
        if (hipGetDevice(&dev) != hipSuccess || hipDeviceGetAttribute(&cus, hipDeviceAttributeMultiprocessorCount, dev) != hipSuccess) { grid = -1; return; }
        if (hipFuncSetAttribute((const void*)hybrid_fwd, hipFuncAttributeMaxDynamicSharedMemorySize, LDS_BYTES) != hipSuccess) { fprintf(stderr, "kernel_launch: hipFuncSetAttribute failed\n"); grid = -1; return; }
        if (hipOccupancyMaxActiveBlocksPerMultiprocessor(&per_cu, (const void*)hybrid_fwd, NWAVES * 64, LDS_BYTES) != hipSuccess || per_cu < 1) { fprintf(stderr, "kernel_launch: occupancy query says %d blocks per CU\n", per_cu); }
        (void)hipGetLastError();
        grid = cus;
    }
    if (grid < 0) return;
    if (hipMemsetAsync((char*)d_ws + WS_CTL, 0, CTL_ZERO_BYTES, stream) != hipSuccess) return;
    Args a{};
    for (int i = 0; i < 23; ++i) a.in[i] = (const float*)d_in[i];
    a.out = (float*)d_out; a.ws = (unsigned char*)d_ws;
    hipLaunchKernelGGL(hybrid_fwd, dim3(grid), dim3(NWAVES * 64), LDS_BYTES, stream, a);
}
```
